# Optimizing an MI355X kernel written in HIP

```python
import math
import jax, jax.numpy as jnp
from jax import lax
import numpy as np

D_MODEL = 1024
BATCH = 4
SEQ = 4096
DEPTH = 1

D_MIX = D_MODEL
D_RWKV = D_MIX // 2
RWKV_HEAD = 64
RWKV_HEADS = D_RWKV // RWKV_HEAD
D_GMLP = D_MIX - D_RWKV
GMLP_GROUPS = 4
GMLP_GROUP_W = D_GMLP // GMLP_GROUPS
CHUNK = 128
DECAY_LORA = 64
ICLR_LORA = 64
GATE_LORA = 128
N_SHIFT = 3 * D_RWKV + DECAY_LORA + ICLR_LORA + GATE_LORA
D_IN = N_SHIFT + 2 * D_GMLP
D_PLE = 256
N_GROUPS = 4
EXPERTS_PER_GROUP = 8
N_EXPERTS = N_GROUPS * EXPERTS_PER_GROUP
TOP_K = 2
D_EXPERT = 512
EXPERT_BLOCK = 128
ALPHA = (2.0 * DEPTH) ** 0.25
BETA = (8.0 * DEPTH) ** -0.25
LN_EPS = 1e-5
GN_EPS = 64e-5
DECAY_SCALE = math.exp(-0.5)

kernel_name = "hymba_rwkv7_gmlp_hmoe_deepnorm"


def layer_norm(x, g, b, eps=LN_EPS):
    xf = x.astype(jnp.float32)
    mu = xf.mean(-1, keepdims=True)
    var = jnp.square(xf - mu).mean(-1, keepdims=True)
    return ((xf - mu) * lax.rsqrt(var + eps) * g + b).astype(x.dtype)


def token_shift(h):
    return jnp.pad(h, ((0, 0), (1, 0), (0, 0)))[:, :-1]


def wkv7_scan(r, w, k, v, a, b):
    Bn, Sn, H, N = r.shape

    def step(state, inp):
        r_t, w_t, k_t, v_t, a_t, b_t = inp
        sa = jnp.einsum('bhij,bhj->bhi', state, a_t)
        state = (state * w_t[:, :, None, :] + sa[..., None] * b_t[:, :, None, :]
                 + v_t[..., None] * k_t[:, :, None, :])
        y = jnp.einsum('bhij,bhj->bhi', state, r_t)
        return state, y

    xs = (jnp.moveaxis(t, 1, 0) for t in (r, w, k, v, a, b))
    s0 = jnp.zeros((Bn, H, N, N), jnp.float32)
    _, y = lax.scan(step, s0, tuple(xs))
    return jnp.moveaxis(y, 0, 1)


def rwkv7_mix(proj, mu, w0, w_decay_up, a0, w_iclr_up, w_gate_up, k_k, k_a, r_k, gn_g, gn_b):
    Bn, Sn, _ = proj.shape
    f32 = jnp.float32
    h = proj[..., :N_SHIFT]
    h = h + (token_shift(h) - h) * mu
    c1, c2, c3 = D_RWKV, 2 * D_RWKV, 3 * D_RWKV
    r, k, v, xw, xa, xg = jnp.split(h, [c1, c2, c3, c3 + DECAY_LORA, c3 + DECAY_LORA + ICLR_LORA], axis=-1)
    d = (w0 + jnp.tanh(xw) @ w_decay_up).astype(f32)
    w = jnp.exp(-DECAY_SCALE * jax.nn.sigmoid(d))
    a = jax.nn.sigmoid(a0 + xa @ w_iclr_up)
    g = jax.nn.sigmoid(xg) @ w_gate_up
    heads = lambda t: t.reshape(Bn, Sn, RWKV_HEADS, RWKV_HEAD).astype(f32)
    kk = heads(k * k_k)
    kk = kk / jnp.maximum(jnp.sqrt(jnp.sum(kk * kk, -1, keepdims=True)), 1e-12)
    k = k * (1 + (a - 1) * k_a)
    rh, kh, vh, ah, wh = heads(r), heads(k), heads(v), heads(a), heads(w)
    y = wkv7_scan(rh, wh, kh, vh, -kk, kk * ah)
    m = y.mean(-1, keepdims=True)
    var = jnp.square(y - m).mean(-1, keepdims=True)
    y = ((y - m) * lax.rsqrt(var + GN_EPS)).reshape(Bn, Sn, D_RWKV) * gn_g + gn_b
    bonus = jnp.sum(rh * kh * r_k, -1, keepdims=True) * vh
    y = y + bonus.reshape(Bn, Sn, D_RWKV)
    return (y * g).astype(proj.dtype)


def gmlp_mix(proj, ln_g, ln_b, w_spatial, b_spatial):
    Bn, Sn, _ = proj.shape
    n_chunks = Sn // CHUNK
    z = jax.nn.gelu(proj[..., N_SHIFT:], approximate=False)
    zu, zv = jnp.split(z, 2, axis=-1)
    shp = (Bn, n_chunks, CHUNK, GMLP_GROUPS, GMLP_GROUP_W)
    zv = layer_norm(zv.reshape(shp), ln_g.reshape(GMLP_GROUPS, GMLP_GROUP_W),
                    ln_b.reshape(GMLP_GROUPS, GMLP_GROUP_W))
    causal = jnp.tril(jnp.ones((CHUNK, CHUNK), dtype=bool))
    ws = jnp.where(causal, w_spatial, 0)
    mixed = jnp.einsum('gts,bcsgd->bctgd', ws, zv) + b_spatial.T[:, :, None]
    return (zu.reshape(shp) * mixed).reshape(Bn, Sn, D_GMLP)


def hmoe(x, w_group_router, b_group_router, w_expert_router, b_expert_router, w_gate, w_up, w_down):
    Bn, Sn, D = x.shape
    f32 = jnp.float32
    T = Bn * Sn
    xf = x.reshape(T, D)
    g_logits = (xf @ w_group_router).astype(f32) + b_group_router
    g_prob = jax.nn.softmax(g_logits, -1)
    g_sel = jnp.argmax(g_logits, -1).astype(jnp.int32)
    p_group = jnp.take_along_axis(g_prob, g_sel[:, None], -1)
    e_all = (xf @ w_expert_router.reshape(D, N_GROUPS * EXPERTS_PER_GROUP)).astype(f32)
    e_all = e_all.reshape(T, N_GROUPS, EXPERTS_PER_GROUP) + b_expert_router
    e_logits = jnp.take_along_axis(e_all, g_sel[:, None, None], 1)[:, 0]
    top_v, top_i = lax.top_k(e_logits, TOP_K)
    gate_w = jax.nn.softmax(top_v, -1) * p_group
    expert_id = g_sel[:, None] * EXPERTS_PER_GROUP + top_i.astype(jnp.int32)
    A = T * TOP_K
    flat_e = expert_id.reshape(A)
    flat_w = gate_w.reshape(A)
    flat_tok = (jnp.arange(A, dtype=jnp.int32) // TOP_K)
    order = jnp.argsort(flat_e)
    e_sorted = flat_e[order]
    counts = jnp.zeros((N_EXPERTS,), jnp.int32).at[flat_e].add(1)
    padded = (counts + EXPERT_BLOCK - 1) // EXPERT_BLOCK * EXPERT_BLOCK
    pad_end = jnp.cumsum(padded)
    pad_start = pad_end - padded
    start = jnp.cumsum(counts) - counts
    dest = pad_start[e_sorted] + jnp.arange(A, dtype=jnp.int32) - start[e_sorted]
    n_blocks = -(-A // EXPERT_BLOCK) + N_EXPERTS
    M = n_blocks * EXPERT_BLOCK
    row_tok = jnp.full((M,), T, jnp.int32).at[dest].set(flat_tok[order])
    row_w = jnp.zeros((M,), f32).at[dest].set(flat_w[order])
    block_e = jnp.minimum(jnp.searchsorted(pad_end, jnp.arange(n_blocks) * EXPERT_BLOCK, side='right'),
                          N_EXPERTS - 1)
    x_pad = jnp.concatenate([xf, jnp.zeros((1, D), xf.dtype)], 0)
    xb = x_pad[row_tok].reshape(n_blocks, EXPERT_BLOCK, D)

    def expert_block(args):
        xblk, e = args
        hid = jax.nn.silu(xblk @ w_gate[e]) * (xblk @ w_up[e])
        return hid @ w_down[e]

    yb = lax.map(expert_block, (xb, block_e)).reshape(M, D)
    y = jnp.zeros((T + 1, D), f32).at[row_tok].add(yb.astype(f32) * row_w[:, None])
    return y[:T].reshape(Bn, Sn, D).astype(x.dtype)


def setup_inputs(seed: int = 0) -> dict:
    key = jax.random.key(seed)
    ks = iter(jax.random.split(key, 48))
    nrm = lambda shape, scale: jax.random.normal(next(ks), shape, jnp.float32) * scale
    L, D = DEPTH, D_MODEL
    return {
        "x": nrm((BATCH, SEQ, D), 1.0),
        "p": nrm((DEPTH, BATCH, SEQ, D_PLE), 1.0),
        "ln_emb_g": 1.0 + nrm((D,), 0.02),
        "ln_emb_b": nrm((D,), 0.02),
        "w_in": nrm((L, D, D_IN), D ** -0.5),
        "mu_shift": jax.random.uniform(next(ks), (L, N_SHIFT), jnp.float32),
        "w0": -2.0 + nrm((L, D_RWKV), 1.0),
        "w_decay_up": nrm((L, DECAY_LORA, D_RWKV), 0.1 * DECAY_LORA ** -0.5),
        "a0": nrm((L, D_RWKV), 0.5),
        "w_iclr_up": nrm((L, ICLR_LORA, D_RWKV), 0.5 * ICLR_LORA ** -0.5),
        "w_gate_up": nrm((L, GATE_LORA, D_RWKV), GATE_LORA ** -0.5),
        "k_k": 0.85 + nrm((L, D_RWKV), 0.02),
        "k_a": 1.0 + nrm((L, D_RWKV), 0.02),
        "r_k": nrm((L, RWKV_HEADS, RWKV_HEAD), 0.1),
        "gn_g": 1.0 + nrm((L, D_RWKV), 0.02),
        "gn_b": nrm((L, D_RWKV), 0.02),
        "gmlp_ln_g": 1.0 + nrm((L, D_GMLP), 0.02),
        "gmlp_ln_b": nrm((L, D_GMLP), 0.02),
        "w_spatial": nrm((L, GMLP_GROUPS, CHUNK, CHUNK), 0.02),
        "b_spatial": 1.0 + nrm((L, GMLP_GROUPS, CHUNK), 0.02),
        "w_out": nrm((L, D_MIX, D), BETA * D_MIX ** -0.5),
        "ln1_g": 1.0 + nrm((L, D), 0.02),
        "ln1_b": nrm((L, D), 0.02),
        "w_group_router": nrm((L, D, N_GROUPS), D ** -0.5),
        "b_group_router": nrm((L, N_GROUPS), 0.01),
        "w_expert_router": nrm((L, D, N_GROUPS, EXPERTS_PER_GROUP), D ** -0.5),
        "b_expert_router": nrm((L, N_GROUPS, EXPERTS_PER_GROUP), 0.01),
        "w_exp_gate": nrm((L, N_EXPERTS, D, D_EXPERT), D ** -0.5),
        "w_exp_up": nrm((L, N_EXPERTS, D, D_EXPERT), D ** -0.5),
        "w_exp_down": nrm((L, N_EXPERTS, D_EXPERT, D), BETA * D_EXPERT ** -0.5),
        "w_ple_gate": nrm((L, D, D), D ** -0.5),
        "b_ple_gate": nrm((L, D), 0.02),
        "w_ple_proj": nrm((L, D_PLE, D), BETA * D_PLE ** -0.5),
        "ln2_g": 1.0 + nrm((L, D), 0.02),
        "ln2_b": nrm((L, D), 0.02),
    }


def reference(x, p, ln_emb_g, ln_emb_b, w_in, mu_shift, w0, w_decay_up, a0, w_iclr_up, w_gate_up,
              k_k, k_a, r_k, gn_g, gn_b, gmlp_ln_g, gmlp_ln_b, w_spatial, b_spatial, w_out,
              ln1_g, ln1_b, w_group_router, b_group_router, w_expert_router, b_expert_router,
              w_exp_gate, w_exp_up, w_exp_down, w_ple_gate, b_ple_gate, w_ple_proj, ln2_g, ln2_b):
    x = layer_norm(x, ln_emb_g, ln_emb_b)
    for i in range(DEPTH):
        proj = x @ w_in[i]
        y_a = rwkv7_mix(proj, mu_shift[i], w0[i], w_decay_up[i], a0[i], w_iclr_up[i], w_gate_up[i],
                        k_k[i], k_a[i], r_k[i], gn_g[i], gn_b[i])
        y_b = gmlp_mix(proj, gmlp_ln_g[i], gmlp_ln_b[i], w_spatial[i], b_spatial[i])
        mix = jnp.concatenate([y_a, y_b], -1) @ w_out[i]
        x = layer_norm(ALPHA * x + mix, ln1_g[i], ln1_b[i])
        ffn = hmoe(x, w_group_router[i], b_group_router[i], w_expert_router[i], b_expert_router[i],
                   w_exp_gate[i], w_exp_up[i], w_exp_down[i])
        ple = jax.nn.sigmoid(x @ w_ple_gate[i] + b_ple_gate[i]) * (p[i] @ w_ple_proj[i])
        x = layer_norm(ALPHA * x + ffn + ple, ln2_g[i], ln2_b[i])
    return x
```

```cpp
#include <hip/hip_runtime.h>
#include <cstdio>
#include <cstdint>

#ifndef MK_PER_PHASE
#define MK_PER_PHASE 0
#endif

constexpr int BATCH = 4, SEQ = 4096, T = BATCH * SEQ, D = 1024, DIN = 2816, NSH = 1792, DR = 512, NH = 8, HD = 64;
constexpr int DG = 512, GG = 4, GW = 128, CH = 128, NE = 32, DE = 512, DP = 256;
constexpr int NSLOT = 40960;
constexpr int NTILE256 = NSLOT / 256;
constexpr float ALPHA = 1.189207115f, LN_EPS = 1e-5f, GN_EPS = 64e-5f, DECAY_SCALE = 0.6065306597f;

constexpr size_t MiB = 1u << 20;
constexpr size_t WS_CTL = 0, CTL_ZERO_BYTES = 1 * MiB;
constexpr size_t WS_STAT0 = 1 * MiB;
constexpr size_t WS_ZSTAT = WS_STAT0 + 128 * 1024;
constexpr size_t WS_TOKE = WS_ZSTAT + 512 * 1024;
constexpr size_t WS_TOKW = WS_TOKE + 128 * 1024;
constexpr size_t WS_TOKP = WS_TOKW + 128 * 1024;
constexpr size_t WS_SLOTTOK = WS_TOKP + 128 * 1024;
constexpr size_t WS_TILEE = WS_SLOTTOK + 256 * 1024;
constexpr size_t WS_XN = 4 * MiB;
constexpr size_t WS_PROJ = 36 * MiB;
constexpr size_t WS_R = 124 * MiB, WS_K = 140 * MiB, WS_V = 156 * MiB, WS_KK = 172 * MiB, WS_KB = 188 * MiB;
constexpr size_t WS_LW = 204 * MiB;
constexpr size_t WS_G = 236 * MiB;
constexpr size_t WS_CAT = 252 * MiB;
constexpr size_t WS_X1B = 36 * MiB;
constexpr size_t WS_HID = 68 * MiB;
constexpr size_t WS_Y = 108 * MiB;
constexpr size_t WS_PP = 188 * MiB;
constexpr size_t WS_END = 284 * MiB;
constexpr int CW_TMO = 0, CW_CODE = 1;
constexpr int CW_ECNT = 1024;
constexpr int CW_BAR = 4096;

constexpr int NWAVES = 8, NTHR = 512;
constexpr int RING_BYTES = 131072, LDSCTL_OFF = RING_BYTES, MISC_OFF = LDSCTL_OFF + 320, LDS_BYTES = 147456;

#define GAS __attribute__((address_space(1)))
#define LAS __attribute__((address_space(3)))
typedef unsigned short bf16;
typedef GAS unsigned gu32;
#define RLX_AGENT __ATOMIC_RELAXED, __HIP_MEMORY_SCOPE_AGENT

__device__ __forceinline__ float bf2f(bf16 v) { return __uint_as_float(((unsigned)v) << 16); }
__device__ __forceinline__ bf16 f2bf(float f) { unsigned u = __float_as_uint(f); return (bf16)((u + 0x7fffu + ((u >> 16) & 1u)) >> 16); }
__device__ __forceinline__ float wave_sum(float v) {
#pragma unroll
    for (int o = 1; o < 64; o <<= 1) v += __shfl_xor(v, o);
    return v;
}
__device__ __forceinline__ float sigmoidf_(float x) { return 1.0f / (1.0f + __expf(-x)); }

#define XB_TMO      128
#define XB_XCNT(j)  (256  + 64 * (j))
#define XB_XSUB(j)  (1280 + 64 * (j))
#define XB_XGEN(j)  (2304 + 64 * (j))
#define XB_TOP      3328
#define XB_TOPGEN   3392
#define XCD_BAR_WORDS 3456
#define XB_SPIN_CAP (1u << 18)
__device__ __forceinline__ unsigned xb_ld(unsigned* p)              { return __hip_atomic_load(p, __ATOMIC_RELAXED, __HIP_MEMORY_SCOPE_AGENT); }
__device__ __forceinline__ unsigned xb_add(unsigned* p, unsigned v) { return __hip_atomic_fetch_add(p, v, __ATOMIC_RELAXED, __HIP_MEMORY_SCOPE_AGENT); }
__device__ __forceinline__ unsigned xb_xcc_id() { return (unsigned)__builtin_amdgcn_s_getreg((3 << 11) | 20) & 0xFu; }
#define XB_SPIN(cond, bar) do { unsigned _sp = 0; while (cond) { __builtin_amdgcn_s_sleep(1); \
    if ((++_sp & 255u) == 0u) { if (xb_ld(&(bar)[XB_TMO])) break; if (_sp > XB_SPIN_CAP) { atomicAdd(&(bar)[XB_TMO], 1u); break; } } } } while (0)
struct XcdBarrier { unsigned* bar; unsigned x; volatile LAS unsigned* st; };
__device__ __forceinline__ XcdBarrier xcd_barrier_post(unsigned* bar, volatile LAS unsigned* st) {
    XcdBarrier b; b.bar = bar; b.x = xb_xcc_id(); b.st = st;
    if (threadIdx.x == 0) (void)xb_add(&bar[XB_XCNT(b.x)], 1u);
    return b;
}
__device__ __forceinline__ void xcd_barrier_complete(unsigned* bar, unsigned x, unsigned& nloc, unsigned& nx) {
    const unsigned G = gridDim.x * gridDim.y * gridDim.z;
    unsigned sum, cnt, mine, sp = 0u;
    for (;;) {
        sum = 0u; cnt = 0u; mine = 0u;
#pragma unroll
        for (unsigned j = 0; j < 16; ++j) { const unsigned c = xb_ld(&bar[XB_XCNT(j)]); sum += c; cnt += (c > 0u) ? 1u : 0u; mine = (j == x) ? c : mine; }
        if (sum == G) break;
        __builtin_amdgcn_s_sleep(1);
        if ((++sp & 255u) == 0u) { if (xb_ld(&bar[XB_TMO])) break; if (sp > XB_SPIN_CAP) { atomicAdd(&bar[XB_TMO], 1u); break; } }
    }
    nloc = mine > 0u ? mine : 1u; nx = cnt > 0u ? cnt : 1u;
}
__device__ __forceinline__ void xcd_barrier(const XcdBarrier& b) {
    asm volatile("s_waitcnt vmcnt(0)" ::: "memory");
    __syncthreads();
    if (threadIdx.x == 0) {
        unsigned* bar = b.bar;
        __builtin_amdgcn_s_waitcnt(0);
        unsigned nloc = b.st[0], nx = b.st[1];
        if (nloc == 0u) { xcd_barrier_complete(bar, b.x, nloc, nx); b.st[0] = nloc; b.st[1] = nx; }
        const unsigned old = xb_add(&bar[XB_XSUB(b.x)], 1u);
        const unsigned gen = old / nloc;
        if (old + 1u == (gen + 1u) * nloc) {
            __builtin_amdgcn_fence(__ATOMIC_RELEASE, "agent");
            asm volatile("s_waitcnt vmcnt(0)" ::: "memory");
            const unsigned og = xb_add(&bar[XB_TOP], 1u);
            const unsigned tg = og / nx;
            if (og + 1u == (tg + 1u) * nx) xb_add(&bar[XB_TOPGEN], 1u);
            else XB_SPIN(xb_ld(&bar[XB_TOPGEN]) == tg, bar);
            __builtin_amdgcn_fence(__ATOMIC_ACQUIRE, "agent");
            xb_add(&bar[XB_XGEN(b.x)], 1u);
            asm volatile("s_waitcnt vmcnt(0)" ::: "memory");
        } else {
            XB_SPIN(xb_ld(&bar[XB_XGEN(b.x)]) == gen, bar);
            __builtin_amdgcn_fence(__ATOMIC_ACQUIRE, "agent");
            asm volatile("s_waitcnt vmcnt(0)" ::: "memory");
        }
    }
    __syncthreads();
}

struct Frame {
    LAS unsigned char* lds;
    float* sm;
    unsigned* ctl;
    int tid, lane, wave, G, bid;
    const float* in[35];
    float* out;
    unsigned char* ws;
};
enum { I_X = 0, I_P, I_LNEG, I_LNEB, I_WIN, I_MU, I_W0, I_WDEC, I_A0, I_WICLR, I_WGATE, I_KK, I_KA, I_RK, I_GNG, I_GNB, I_GLNG, I_GLNB, I_WSP, I_BSP,
       I_WOUT, I_LN1G, I_LN1B, I_WGR, I_BGR, I_WER, I_BER, I_WEG, I_WEU, I_WED, I_WPG, I_BPG, I_WPP, I_LN2G, I_LN2B };

template <class AF, class BF, class EF>
__device__ __forceinline__ void sgemm_tile(float* sA, float* sB, int tid, int m0, int n0, int K, AF af, BF bf, EF ef) {
    const int tx = tid & 15, ty = tid >> 4;
    float acc[4][4];
#pragma unroll
    for (int i = 0; i < 4; ++i)
#pragma unroll
        for (int j = 0; j < 4; ++j) acc[i][j] = 0.f;
    for (int k0 = 0; k0 < K; k0 += 16) {
        float ra[4], rb[2];
#pragma unroll
        for (int i = 0; i < 4; ++i) { const int idx = tid + i * 512, m = idx >> 4, k = idx & 15; ra[i] = af(m0 + m, k0 + k); }
#pragma unroll
        for (int i = 0; i < 2; ++i) { const int idx = tid + i * 512, k = idx >> 6, n = idx & 63; rb[i] = bf(k0 + k, n0 + n); }
        __syncthreads();
#pragma unroll
        for (int i = 0; i < 4; ++i) { const int idx = tid + i * 512, m = idx >> 4, k = idx & 15; sA[k * 132 + m] = ra[i]; }
#pragma unroll
        for (int i = 0; i < 2; ++i) { const int idx = tid + i * 512, k = idx >> 6, n = idx & 63; sB[k * 68 + n] = rb[i]; }
        __syncthreads();
#pragma unroll
        for (int k = 0; k < 16; ++k) {
            const float4 a = *(const float4*)(sA + k * 132 + ty * 4), b = *(const float4*)(sB + k * 68 + tx * 4);
            const float av[4] = {a.x, a.y, a.z, a.w}, bv[4] = {b.x, b.y, b.z, b.w};
#pragma unroll
            for (int i = 0; i < 4; ++i)
#pragma unroll
                for (int j = 0; j < 4; ++j) acc[i][j] = fmaf(av[i], bv[j], acc[i][j]);
        }
    }
    ef(m0 + ty * 4, n0 + tx * 4, acc);
    __syncthreads();
}

__device__ __forceinline__ void ph_ln0(Frame& F) {
    const float* x = F.in[I_X]; const float* g = F.in[I_LNEG]; const float* b = F.in[I_LNEB];
    bf16* XN = (bf16*)(F.ws + WS_XN); float* st = (float*)(F.ws + WS_STAT0);
    const int gw = F.bid * NWAVES + F.wave, NGW = F.G * NWAVES;
    for (int m = gw; m < T; m += NGW) {
        const float* xr = x + (size_t)m * D; float v[16]; float s = 0.f;
#pragma unroll
        for (int j = 0; j < 16; ++j) { v[j] = xr[F.lane + 64 * j]; s += v[j]; }
        const float mean = wave_sum(s) * (1.f / D); float q = 0.f;
#pragma unroll
        for (int j = 0; j < 16; ++j) { const float d = v[j] - mean; q += d * d; }
        const float rstd = 1.0f / sqrtf(wave_sum(q) * (1.f / D) + LN_EPS);
#pragma unroll
        for (int j = 0; j < 16; ++j) { const int c = F.lane + 64 * j; XN[(size_t)m * D + c] = f2bf((v[j] - mean) * rstd * g[c] + b[c]); }
        if (F.lane == 0) { st[2 * m] = mean; st[2 * m + 1] = rstd; }
    }
}
__device__ __forceinline__ void ph_proj(Frame& F) {
    const bf16* XN = (const bf16*)(F.ws + WS_XN); const float* W = F.in[I_WIN]; bf16* PR = (bf16*)(F.ws + WS_PROJ);
    float* sA = F.sm; float* sB = F.sm + 16 * 132;
    const int ntn = DIN / 64, ntm = T / 128;
    for (int tile = F.bid; tile < ntm * ntn; tile += F.G) {
        const int m0 = (tile / ntn) * 128, n0 = (tile % ntn) * 64;
        sgemm_tile(sA, sB, F.tid, m0, n0, D,
            [&](int m, int k) { return bf2f(XN[(size_t)m * D + k]); },
            [&](int k, int n) { return W[(size_t)k * DIN + n]; },
            [&](int mb, int nb, float (&acc)[4][4]) {
#pragma unroll
                for (int i = 0; i < 4; ++i)
#pragma unroll
                    for (int j = 0; j < 4; ++j) { float v = acc[i][j]; const int n = nb + j; if (n >= NSH) v = 0.5f * v * (1.0f + erff(v * 0.70710678f)); PR[(size_t)(mb + i) * DIN + n] = f2bf(v); }
            });
    }
}
__device__ __forceinline__ void ph_prep(Frame& F) {
    const bf16* PR = (const bf16*)(F.ws + WS_PROJ);
    const float* mu = F.in[I_MU]; const float* w0 = F.in[I_W0]; const float* Wd = F.in[I_WDEC]; const float* a0 = F.in[I_A0]; const float* Wa = F.in[I_WICLR]; const float* Wg = F.in[I_WGATE];
    const float* k_k = F.in[I_KK]; const float* k_a = F.in[I_KA];
    bf16* oR = (bf16*)(F.ws + WS_R); bf16* oK = (bf16*)(F.ws + WS_K); bf16* oV = (bf16*)(F.ws + WS_V); bf16* oKK = (bf16*)(F.ws + WS_KK); bf16* oKB = (bf16*)(F.ws + WS_KB);
    float* oLW = (float*)(F.ws + WS_LW); bf16* oG = (bf16*)(F.ws + WS_G);
    float* h = F.sm;
    const int c = F.tid;
    for (int t = F.bid; t < T; t += F.G) {
        __syncthreads();
        for (int cc = c; cc < NSH; cc += NTHR) {
            const float cur = bf2f(PR[(size_t)t * DIN + cc]);
            const float prev = (t % SEQ == 0) ? 0.f : bf2f(PR[(size_t)(t - 1) * DIN + cc]);
            float v = cur + (prev - cur) * mu[cc];
            if (cc >= 1536 && cc < 1600) v = tanhf(v);
            if (cc >= 1664) v = sigmoidf_(v);
            h[cc] = v;
        }
        __syncthreads();
        float d = w0[c], ai = a0[c], g = 0.f;
#pragma unroll 4
        for (int j = 0; j < 64; ++j) { d = fmaf(h[1536 + j], Wd[j * DR + c], d); ai = fmaf(h[1600 + j], Wa[j * DR + c], ai); }
#pragma unroll 4
        for (int j = 0; j < 128; ++j) g = fmaf(h[1664 + j], Wg[j * DR + c], g);
        const float lw = -DECAY_SCALE * sigmoidf_(d), ic = sigmoidf_(ai);
        const float k = h[512 + c]; float kk = k * k_k[c];
        const float nrm = sqrtf(wave_sum(kk * kk)); kk = kk / fmaxf(nrm, 1e-12f);
        const float kmod = k * (1.0f + (ic - 1.0f) * k_a[c]);
        const size_t o = (size_t)t * DR + c;
        oR[o] = f2bf(h[c]); oK[o] = f2bf(kmod); oV[o] = f2bf(h[1024 + c]); oKK[o] = f2bf(kk); oKB[o] = f2bf(kk * ic); oLW[o] = lw; oG[o] = f2bf(g);
    }
    __syncthreads();
}
__device__ __forceinline__ void ph_zstat(Frame& F) {
    const bf16* PR = (const bf16*)(F.ws + WS_PROJ); float* zs = (float*)(F.ws + WS_ZSTAT);
    const int gw = F.bid * NWAVES + F.wave, NGW = F.G * NWAVES;
    for (int it = gw; it < T * GG; it += NGW) {
        const int t = it >> 2, g = it & 3; const bf16* p = PR + (size_t)t * DIN + NSH + DG + g * GW;
        const float a = bf2f(p[F.lane]), b = bf2f(p[F.lane + 64]);
        const float mean = wave_sum(a + b) * (1.f / GW); const float da = a - mean, db = b - mean;
        const float rstd = 1.0f / sqrtf(wave_sum(da * da + db * db) * (1.f / GW) + LN_EPS);
        if (F.lane == 0) { zs[2 * it] = mean; zs[2 * it + 1] = rstd; }
    }
}
__device__ __forceinline__ void ph_gmlp(Frame& F) {
    const bf16* PR = (const bf16*)(F.ws + WS_PROJ); const float* zs = (const float*)(F.ws + WS_ZSTAT);
    const float* lg = F.in[I_GLNG]; const float* lb = F.in[I_GLNB]; const float* wsp = F.in[I_WSP]; const float* bsp = F.in[I_BSP];
    bf16* CAT = (bf16*)(F.ws + WS_CAT);
    const int c = F.tid, g = c >> 7; const float gg = lg[c], gb = lb[c];
    for (int t = F.bid; t < T; t += F.G) {
        const int tl = t & (CH - 1), t0 = t - tl; const float* wrow = wsp + ((size_t)g * CH + tl) * CH;
        float acc = bsp[g * CH + tl];
        for (int sl = 0; sl <= tl; ++sl) {
            const int s = t0 + sl; const float zv = bf2f(PR[(size_t)s * DIN + NSH + DG + c]);
            const float zn = (zv - zs[(s * 4 + g) * 2]) * zs[(s * 4 + g) * 2 + 1] * gg + gb;
            acc = fmaf(wrow[sl], zn, acc);
        }
        const float zu = bf2f(PR[(size_t)t * DIN + NSH + c]);
        CAT[(size_t)t * D + DR + c] = f2bf(zu * acc);
    }
}
__device__ __forceinline__ void ph_wkv_naive(Frame& F) {
    const bf16* iR = (const bf16*)(F.ws + WS_R); const bf16* iK = (const bf16*)(F.ws + WS_K); const bf16* iV = (const bf16*)(F.ws + WS_V); const bf16* iKK = (const bf16*)(F.ws + WS_KK); const bf16* iKB = (const bf16*)(F.ws + WS_KB);
    const float* iLW = (const float*)(F.ws + WS_LW); const bf16* iG = (const bf16*)(F.ws + WS_G);
    const float* r_k = F.in[I_RK]; const float* gng = F.in[I_GNG]; const float* gnb = F.in[I_GNB];
    bf16* CAT = (bf16*)(F.ws + WS_CAT);
    if (F.wave != 0) return;
    float* sv = F.sm;
    for (int seq = F.bid; seq < BATCH * NH; seq += F.G) {
        const int b = seq / NH, hh = seq % NH; const int ch = hh * HD + F.lane;
        float st[64];
#pragma unroll
        for (int j = 0; j < 64; ++j) st[j] = 0.f;
        const float rk = r_k[ch], gg = gng[ch], gb = gnb[ch];
        for (int tb = 0; tb < SEQ; tb += 16) {
            for (int s = 0; s < 16; ++s) {
                const size_t o = (size_t)(b * SEQ + tb + s) * DR + ch;
                sv[(s * 5 + 0) * 64 + F.lane] = -bf2f(iKK[o]);
                sv[(s * 5 + 1) * 64 + F.lane] = __expf(iLW[o]);
                sv[(s * 5 + 2) * 64 + F.lane] = bf2f(iKB[o]);
                sv[(s * 5 + 3) * 64 + F.lane] = bf2f(iK[o]);
                sv[(s * 5 + 4) * 64 + F.lane] = bf2f(iR[o]);
            }
            __builtin_amdgcn_s_waitcnt(0); __builtin_amdgcn_wave_barrier();
            for (int s = 0; s < 16; ++s) {
                const size_t o = (size_t)(b * SEQ + tb + s) * DR + ch;
                const float v = bf2f(iV[o]);
                const float* pa = sv + (s * 5 + 0) * 64; const float* pw = pa + 64; const float* pb = pa + 128; const float* pk = pa + 192; const float* pr = pa + 256;
                float sa = 0.f;
#pragma unroll
                for (int j = 0; j < 64; ++j) sa = fmaf(st[j], pa[j], sa);
                float y = 0.f;
#pragma unroll
                for (int j = 0; j < 64; ++j) { st[j] = fmaf(st[j], pw[j], fmaf(sa, pb[j], v * pk[j])); y = fmaf(st[j], pr[j], y); }
                const float m = wave_sum(y) * (1.f / 64.f); const float dy = y - m; const float var = wave_sum(dy * dy) * (1.f / 64.f);
                const float yn = dy * (1.0f / sqrtf(var + GN_EPS)) * gg + gb;
                const float bonus = wave_sum(pr[F.lane] * pk[F.lane] * rk) * v;
                CAT[(size_t)(b * SEQ + tb + s) * D + ch] = f2bf((yn + bonus) * bf2f(iG[o]));
            }
            __builtin_amdgcn_s_waitcnt(0); __builtin_amdgcn_wave_barrier();
        }
    }
}
__device__ __forceinline__ void ph_wout(Frame& F) {
    const bf16* CAT = (const bf16*)(F.ws + WS_CAT); const float* W = F.in[I_WOUT]; const float* x = F.in[I_X]; const float* st = (const float*)(F.ws + WS_STAT0);
    const float* g = F.in[I_LNEG]; const float* b = F.in[I_LNEB]; float* out = F.out;
    float* sA = F.sm; float* sB = F.sm + 16 * 132;
    const int ntn = D / 64, ntm = T / 128;
    for (int tile = F.bid; tile < ntm * ntn; tile += F.G) {
        const int m0 = (tile / ntn) * 128, n0 = (tile % ntn) * 64;
        sgemm_tile(sA, sB, F.tid, m0, n0, D,
            [&](int m, int k) { return bf2f(CAT[(size_t)m * D + k]); },
            [&](int k, int n) { return W[(size_t)k * D + n]; },
            [&](int mb, int nb, float (&acc)[4][4]) {
#pragma unroll
                for (int i = 0; i < 4; ++i) { const int m = mb + i; const float mean = st[2 * m], rstd = st[2 * m + 1];
#pragma unroll
                    for (int j = 0; j < 4; ++j) { const int n = nb + j; const float xn = (x[(size_t)m * D + n] - mean) * rstd * g[n] + b[n]; out[(size_t)m * D + n] = ALPHA * xn + acc[i][j]; } }
            });
    }
}
__device__ __forceinline__ void ph_rowln(Frame& F, const float* g, const float* b, bf16* xb) {
    float* out = F.out;
    const int gw = F.bid * NWAVES + F.wave, NGW = F.G * NWAVES;
    for (int m = gw; m < T; m += NGW) {
        float* xr = out + (size_t)m * D; float v[16]; float s = 0.f;
#pragma unroll
        for (int j = 0; j < 16; ++j) { v[j] = xr[F.lane + 64 * j]; s += v[j]; }
        const float mean = wave_sum(s) * (1.f / D); float q = 0.f;
#pragma unroll
        for (int j = 0; j < 16; ++j) { const float d = v[j] - mean; q += d * d; }
        const float rstd = 1.0f / sqrtf(wave_sum(q) * (1.f / D) + LN_EPS);
#pragma unroll
        for (int j = 0; j < 16; ++j) { const int c = F.lane + 64 * j; const float o = (v[j] - mean) * rstd * g[c] + b[c]; xr[c] = o; if (xb) xb[(size_t)m * D + c] = f2bf(o); }
    }
}
__device__ __forceinline__ void ph_route(Frame& F) {
    const float* x1 = F.out; const float* Wgr = F.in[I_WGR]; const float* bgr = F.in[I_BGR]; const float* Wer = F.in[I_WER]; const float* ber = F.in[I_BER];
    int* tokE = (int*)(F.ws + WS_TOKE); float* tokW = (float*)(F.ws + WS_TOKW); int* tokP = (int*)(F.ws + WS_TOKP); int* slotTok = (int*)(F.ws + WS_SLOTTOK);
    unsigned* ecnt = F.ctl + CW_ECNT;
    for (int i = F.bid * NTHR + F.tid; i < NSLOT; i += F.G * NTHR) slotTok[i] = -1;
    const int gw = F.bid * NWAVES + F.wave, NGW = F.G * NWAVES;
    for (int t = gw; t < T; t += NGW) {
        const float* xr = x1 + (size_t)t * D; float acc = 0.f; const int o = F.lane;
        if (o < 4) { for (int k = 0; k < D; ++k) acc = fmaf(xr[k], Wgr[k * 4 + o], acc); acc += bgr[o]; }
        else if (o < 36) { for (int k = 0; k < D; ++k) acc = fmaf(xr[k], Wer[k * 32 + (o - 4)], acc); acc += ber[o - 4]; }
        float gl[4];
#pragma unroll
        for (int j = 0; j < 4; ++j) gl[j] = __shfl(acc, j);
        int gs = 0; float gm = gl[0];
#pragma unroll
        for (int j = 1; j < 4; ++j) if (gl[j] > gm) { gm = gl[j]; gs = j; }
        float se = 0.f;
#pragma unroll
        for (int j = 0; j < 4; ++j) se += __expf(gl[j] - gm);
        const float pg = 1.0f / se;
        float el[8];
#pragma unroll
        for (int j = 0; j < 8; ++j) el[j] = __shfl(acc, 4 + gs * 8 + j);
        int i1 = 0; float v1 = el[0];
#pragma unroll
        for (int j = 1; j < 8; ++j) if (el[j] > v1) { v1 = el[j]; i1 = j; }
        int i2 = -1; float v2 = -3.0e38f;
#pragma unroll
        for (int j = 0; j < 8; ++j) if (j != i1 && el[j] > v2) { v2 = el[j]; i2 = j; }
        const float e2 = __expf(v2 - v1), w1 = pg / (1.0f + e2), w2 = pg * e2 / (1.0f + e2);
        if (F.lane == 0) {
            const int ea = gs * 8 + i1, eb = gs * 8 + i2;
            tokE[2 * t] = ea; tokE[2 * t + 1] = eb; tokW[2 * t] = w1; tokW[2 * t + 1] = w2;
            tokP[2 * t] = (int)atomicAdd(&ecnt[ea], 1u); tokP[2 * t + 1] = (int)atomicAdd(&ecnt[eb], 1u);
        }
    }
}
__device__ __forceinline__ void ph_bucket(Frame& F) {
    int* tokE = (int*)(F.ws + WS_TOKE); int* tokP = (int*)(F.ws + WS_TOKP); int* slotTok = (int*)(F.ws + WS_SLOTTOK); int* tileE = (int*)(F.ws + WS_TILEE);
    unsigned* ecnt = F.ctl + CW_ECNT;
    int* pstart = (int*)F.sm;
    __syncthreads();
    if (F.tid == 0) { int s = 0; for (int e = 0; e < NE; ++e) { pstart[e] = s; s += (((int)xb_ld(&ecnt[e]) + 255) / 256) * 256; } pstart[NE] = s; }
    __syncthreads();
    if (F.bid == 0) for (int tl = F.tid; tl < NTILE256; tl += NTHR) { int e = -1; for (int j = 0; j < NE; ++j) if (tl * 256 >= pstart[j] && tl * 256 < pstart[j + 1]) e = j; tileE[tl] = e; }
    for (int i = F.bid * NTHR + F.tid; i < 2 * T; i += F.G * NTHR) { const int slot = pstart[tokE[i]] + tokP[i]; tokP[i] = slot; slotTok[slot] = i >> 1; }
    __syncthreads();
}
__device__ __forceinline__ void ph_up(Frame& F) {
    const bf16* X1B = (const bf16*)(F.ws + WS_X1B); const float* Weg = F.in[I_WEG]; const float* Weu = F.in[I_WEU]; bf16* HID = (bf16*)(F.ws + WS_HID);
    const int* slotTok = (const int*)(F.ws + WS_SLOTTOK); const int* tileE = (const int*)(F.ws + WS_TILEE);
    float* sA = F.sm; float* sB = F.sm + 16 * 132;
    const int ntn = (2 * DE) / 64, ntm = NSLOT / 128;
    for (int tile = F.bid; tile < ntm * ntn; tile += F.G) {
        const int m0 = (tile / ntn) * 128, n0 = (tile % ntn) * 64; const int e = tileE[m0 >> 8];
        if (e < 0) continue;
        const float* wg = Weg + (size_t)e * D * DE; const float* wu = Weu + (size_t)e * D * DE;
        sgemm_tile(sA, sB, F.tid, m0, n0, D,
            [&](int m, int k) { const int tk = slotTok[m]; return tk >= 0 ? bf2f(X1B[(size_t)tk * D + k]) : 0.f; },
            [&](int k, int n) { return (n & 1) ? wu[(size_t)k * DE + (n >> 1)] : wg[(size_t)k * DE + (n >> 1)]; },
            [&](int mb, int nb, float (&acc)[4][4]) {
#pragma unroll
                for (int i = 0; i < 4; ++i)
#pragma unroll
                    for (int j = 0; j < 2; ++j) { const float gt = acc[i][2 * j], up = acc[i][2 * j + 1]; HID[(size_t)(mb + i) * DE + (nb >> 1) + j] = f2bf(gt * sigmoidf_(gt) * up); }
            });
    }
}
__device__ __forceinline__ void ph_down(Frame& F) {
    const bf16* HID = (const bf16*)(F.ws + WS_HID); const float* Wed = F.in[I_WED]; bf16* Y = (bf16*)(F.ws + WS_Y);
    const int* tileE = (const int*)(F.ws + WS_TILEE);
    float* sA = F.sm; float* sB = F.sm + 16 * 132;
    const int ntn = D / 64, ntm = NSLOT / 128;
    for (int tile = F.bid; tile < ntm * ntn; tile += F.G) {
        const int m0 = (tile / ntn) * 128, n0 = (tile % ntn) * 64; const int e = tileE[m0 >> 8];
        if (e < 0) continue;
        const float* wd = Wed + (size_t)e * DE * D;
        sgemm_tile(sA, sB, F.tid, m0, n0, DE,
            [&](int m, int k) { return bf2f(HID[(size_t)m * DE + k]); },
            [&](int k, int n) { return wd[(size_t)k * D + n]; },
            [&](int mb, int nb, float (&acc)[4][4]) {
#pragma unroll
                for (int i = 0; i < 4; ++i)
#pragma unroll
                    for (int j = 0; j < 4; ++j) Y[(size_t)(mb + i) * D + nb + j] = f2bf(acc[i][j]);
            });
    }
}
__device__ __forceinline__ void ph_pproj(Frame& F) {
    const float* P = F.in[I_P]; const float* W = F.in[I_WPP]; bf16* PP = (bf16*)(F.ws + WS_PP);
    float* sA = F.sm; float* sB = F.sm + 16 * 132;
    const int ntn = D / 64, ntm = T / 128;
    for (int tile = F.bid; tile < ntm * ntn; tile += F.G) {
        const int m0 = (tile / ntn) * 128, n0 = (tile % ntn) * 64;
        sgemm_tile(sA, sB, F.tid, m0, n0, DP,
            [&](int m, int k) { return P[(size_t)m * DP + k]; },
            [&](int k, int n) { return W[(size_t)k * D + n]; },
            [&](int mb, int nb, float (&acc)[4][4]) {
#pragma unroll
                for (int i = 0; i < 4; ++i)
#pragma unroll
                    for (int j = 0; j < 4; ++j) PP[(size_t)(mb + i) * D + nb + j] = f2bf(acc[i][j]);
            });
    }
}
__device__ __forceinline__ void ph_gate(Frame& F) {
    const bf16* X1B = (const bf16*)(F.ws + WS_X1B); const float* W = F.in[I_WPG]; const float* bpg = F.in[I_BPG]; const bf16* PP = (const bf16*)(F.ws + WS_PP); const bf16* Y = (const bf16*)(F.ws + WS_Y);
    const int* tokP = (const int*)(F.ws + WS_TOKP); const float* tokW = (const float*)(F.ws + WS_TOKW); float* out = F.out;
    float* sA = F.sm; float* sB = F.sm + 16 * 132;
    const int ntn = D / 64, ntm = T / 128;
    for (int tile = F.bid; tile < ntm * ntn; tile += F.G) {
        const int m0 = (tile / ntn) * 128, n0 = (tile % ntn) * 64;
        sgemm_tile(sA, sB, F.tid, m0, n0, D,
            [&](int m, int k) { return bf2f(X1B[(size_t)m * D + k]); },
            [&](int k, int n) { return W[(size_t)k * D + n]; },
            [&](int mb, int nb, float (&acc)[4][4]) {
#pragma unroll
                for (int i = 0; i < 4; ++i) { const int m = mb + i; const int s0 = tokP[2 * m], s1 = tokP[2 * m + 1]; const float w0 = tokW[2 * m], w1 = tokW[2 * m + 1];
#pragma unroll
                    for (int j = 0; j < 4; ++j) { const int n = nb + j; const size_t o = (size_t)m * D + n;
                        const float ffn = w0 * bf2f(Y[(size_t)s0 * D + n]) + w1 * bf2f(Y[(size_t)s1 * D + n]);
                        out[o] = ALPHA * out[o] + ffn + sigmoidf_(acc[i][j] + bpg[n]) * bf2f(PP[o]); } }
            });
    }
}

constexpr int NPHASE = 15;
struct Args { const float* in[35]; float* out; unsigned char* ws; int ph_lo, ph_hi; };
__global__ void __launch_bounds__(NTHR, 2) mk_fwd(Args args) {
    extern __shared__ __attribute__((aligned(16))) unsigned char lds[];
    Frame F;
    F.lds = (LAS unsigned char*)lds; F.sm = (float*)lds;
    F.tid = threadIdx.x; F.lane = F.tid & 63; F.wave = __builtin_amdgcn_readfirstlane(F.tid >> 6); F.G = gridDim.x; F.bid = blockIdx.x;
    F.ws = args.ws; F.out = args.out; F.ctl = (unsigned*)(args.ws + WS_CTL);
#pragma unroll
    for (int i = 0; i < 35; ++i) F.in[i] = args.in[i];
    volatile LAS unsigned* MISC = (volatile LAS unsigned*)(F.lds + MISC_OFF);
    for (int u = F.tid; u < (LDS_BYTES - LDSCTL_OFF) / 4; u += NTHR) ((LAS unsigned*)(F.lds + LDSCTL_OFF))[u] = 0u;
    __syncthreads();
    XcdBarrier bar; bar.bar = F.ctl + CW_BAR; bar.x = 0; bar.st = nullptr;
    if (!MK_PER_PHASE) bar = xcd_barrier_post(F.ctl + CW_BAR, MISC + 8);
    const int lo = args.ph_lo, hi = args.ph_hi;
#define IN(k) (lo <= (k) && (k) < hi)
#define SEAM(k) do { if (IN(k) && IN((k) + 1)) xcd_barrier(bar); } while (0)
    if (IN(0)) ph_ln0(F);
    SEAM(0);
    if (IN(1)) ph_proj(F);
    SEAM(1);
    if (IN(2)) { ph_prep(F); ph_zstat(F); }
    SEAM(2);
    if (IN(3)) ph_gmlp(F);
    SEAM(3);
    if (IN(4)) ph_wkv_naive(F);
    SEAM(4);
    if (IN(5)) ph_wout(F);
    SEAM(5);
    if (IN(6)) ph_rowln(F, F.in[I_LN1G], F.in[I_LN1B], (bf16*)(F.ws + WS_X1B));
    SEAM(6);
    if (IN(7)) ph_route(F);
    SEAM(7);
    if (IN(8)) ph_bucket(F);
    SEAM(8);
    if (IN(9)) ph_up(F);
    SEAM(9);
    if (IN(10)) ph_down(F);
    SEAM(10);
    if (IN(11)) ph_pproj(F);
    SEAM(11);
    if (IN(12)) ph_gate(F);
    SEAM(12);
    if (IN(13)) ph_rowln(F, F.in[I_LN2G], F.in[I_LN2B], nullptr);
#undef IN
#undef SEAM
}

extern "C" void kernel_launch(void* const* d_in, const int* in_sizes, int n_in, void* d_out, int out_size, void* d_ws, size_t ws_size, hipStream_t stream) {
    static int grid = 0;
    if (grid == 0) {
        if (n_in != 35 || out_size != T * D || ws_size < WS_END) { fprintf(stderr, "kernel_launch: unexpected shapes n_in %d out %d ws %zu (need %zu)\n", n_in, out_size, ws_size, (size_t)WS_END); grid = -1; return; }
        int dev = 0, cus = 0, per_cu = 0;
        if (hipGetDevice(&dev) != hipSuccess || hipDeviceGetAttribute(&cus, hipDeviceAttributeMultiprocessorCount, dev) != hipSuccess) { grid = -1; return; }
        if (hipFuncSetAttribute((const void*)mk_fwd, hipFuncAttributeMaxDynamicSharedMemorySize, LDS_BYTES) != hipSuccess) { fprintf(stderr, "kernel_launch: hipFuncSetAttribute failed\n"); grid = -1; return; }
        if (hipOccupancyMaxActiveBlocksPerMultiprocessor(&per_cu, (const void*)mk_fwd, NTHR, LDS_BYTES) != hipSuccess || per_cu < 1) fprintf(stderr, "kernel_launch: occupancy query says %d\n", per_cu);
        (void)hipGetLastError();
        grid = cus;
    }
    if (grid < 0) return;
    if (hipMemsetAsync((char*)d_ws + WS_CTL, 0, CTL_ZERO_BYTES, stream) != hipSuccess) return;
    Args a{};
    for (int i = 0; i < 35; ++i) a.in[i] = (const float*)d_in[i];
    a.out = (float*)d_out; a.ws = (unsigned char*)d_ws;
#if MK_PER_PHASE
    for (int ph = 0; ph < NPHASE - 1; ++ph) { a.ph_lo = ph; a.ph_hi = ph + 1; hipLaunchKernelGGL(mk_fwd, dim3(grid), dim3(NTHR), LDS_BYTES, stream, a); }
#else
    a.ph_lo = 0; a.ph_hi = NPHASE; hipLaunchKernelGGL(mk_fwd, dim3(grid), dim3(NTHR), LDS_BYTES, stream, a);
#endif
}
```

```cpp
#include <hip/hip_runtime.h>
#include <cstdio>
#include <cstdint>

#ifndef FAST_PROJ
#define FAST_PROJ 1
#endif
#ifndef FAST_WOUT
#define FAST_WOUT 1
#endif
#ifndef FAST_UP
#define FAST_UP 1
#endif
#ifndef FAST_DOWN
#define FAST_DOWN 1
#endif
#ifndef FAST_PP
#define FAST_PP 1
#endif
#ifndef FAST_GATE
#define FAST_GATE 1
#endif
#ifndef MK_PER_PHASE
#define MK_PER_PHASE 0
#endif

constexpr int BATCH = 4, SEQ = 4096, T = BATCH * SEQ, D = 1024, DIN = 2816, NSH = 1792, DR = 512, NH = 8, HD = 64;
constexpr int DG = 512, GG = 4, GW = 128, CH = 128, NE = 32, DE = 512, DP = 256;
constexpr int NSLOT = 40960;
constexpr int NTILE256 = NSLOT / 256;
constexpr float ALPHA = 1.189207115f, LN_EPS = 1e-5f, GN_EPS = 64e-5f, DECAY_SCALE = 0.6065306597f;

constexpr size_t MiB = 1u << 20;
constexpr size_t WS_CTL = 0, CTL_ZERO_BYTES = 1 * MiB;
constexpr size_t WS_STAT0 = 1 * MiB;
constexpr size_t WS_ZSTAT = WS_STAT0 + 128 * 1024;
constexpr size_t WS_TOKE = WS_ZSTAT + 512 * 1024;
constexpr size_t WS_TOKW = WS_TOKE + 128 * 1024;
constexpr size_t WS_TOKP = WS_TOKW + 128 * 1024;
constexpr size_t WS_SLOTTOK = WS_TOKP + 128 * 1024;
constexpr size_t WS_TILEE = WS_SLOTTOK + 256 * 1024;
constexpr size_t WS_WIN_T = 4 * MiB;
constexpr size_t WS_WOUT_T = 10 * MiB, WS_WPG_T = 12 * MiB, WS_WPP_T = 14 * MiB;
constexpr size_t WS_XN = 15 * MiB;
constexpr size_t WS_PROJ = 47 * MiB;
constexpr size_t WS_R = 135 * MiB, WS_K = 151 * MiB, WS_V = 167 * MiB, WS_KK = 183 * MiB, WS_KB = 199 * MiB, WS_LW = 215 * MiB, WS_G = 231 * MiB;
constexpr size_t WS_CAT = 247 * MiB;
constexpr size_t WS_X1B = WS_XN;
constexpr size_t WS_WGU_T = 47 * MiB;
constexpr size_t WS_WD_T = 111 * MiB;
constexpr size_t WS_HID = 143 * MiB;
constexpr size_t WS_Y = 183 * MiB;
constexpr size_t WS_PB = 263 * MiB;
constexpr size_t WS_PP = 143 * MiB;
constexpr size_t WS_END = 284 * MiB;
constexpr int CW_TMO = 0, CW_CODE = 1;
constexpr int CW_ECNT = 1024;
constexpr int CW_NTILES = 1100;
constexpr int CW_BAR = 4096;

constexpr int NWAVES = 8, NTHR = 512;
constexpr int RING_BYTES = 131072, LDSCTL_OFF = RING_BYTES, MISC_OFF = LDSCTL_OFF + 320, LDS_BYTES = 147456;

#define GAS __attribute__((address_space(1)))
#define LAS __attribute__((address_space(3)))
typedef unsigned short bf16;
typedef GAS unsigned gu32;
#define RLX_AGENT __ATOMIC_RELAXED, __HIP_MEMORY_SCOPE_AGENT

__device__ __forceinline__ float bf2f(bf16 v) { return __uint_as_float(((unsigned)v) << 16); }
__device__ __forceinline__ bf16 f2bf(float f) { unsigned u = __float_as_uint(f); return (bf16)((u + 0x7fffu + ((u >> 16) & 1u)) >> 16); }
__device__ __forceinline__ float wave_sum(float v) {
#pragma unroll
    for (int o = 1; o < 64; o <<= 1) v += __shfl_xor(v, o);
    return v;
}
__device__ __forceinline__ float sigmoidf_(float x) { return 1.0f / (1.0f + __expf(-x)); }

#define XB_TMO      128
#define XB_XCNT(j)  (256  + 64 * (j))
#define XB_XSUB(j)  (1280 + 64 * (j))
#define XB_XGEN(j)  (2304 + 64 * (j))
#define XB_TOP      3328
#define XB_TOPGEN   3392
#define XCD_BAR_WORDS 3456
#define XB_SPIN_CAP (1u << 18)
__device__ __forceinline__ unsigned xb_ld(unsigned* p)              { return __hip_atomic_load(p, __ATOMIC_RELAXED, __HIP_MEMORY_SCOPE_AGENT); }
__device__ __forceinline__ unsigned xb_add(unsigned* p, unsigned v) { return __hip_atomic_fetch_add(p, v, __ATOMIC_RELAXED, __HIP_MEMORY_SCOPE_AGENT); }
__device__ __forceinline__ unsigned xb_xcc_id() { return (unsigned)__builtin_amdgcn_s_getreg((3 << 11) | 20) & 0xFu; }
#define XB_SPIN(cond, bar) do { unsigned _sp = 0; while (cond) { __builtin_amdgcn_s_sleep(1); \
    if ((++_sp & 255u) == 0u) { if (xb_ld(&(bar)[XB_TMO])) break; if (_sp > XB_SPIN_CAP) { atomicAdd(&(bar)[XB_TMO], 1u); break; } } } } while (0)
struct XcdBarrier { unsigned* bar; unsigned x; volatile LAS unsigned* st; };
__device__ __forceinline__ XcdBarrier xcd_barrier_post(unsigned* bar, volatile LAS unsigned* st) {
    XcdBarrier b; b.bar = bar; b.x = xb_xcc_id(); b.st = st;
    if (threadIdx.x == 0) (void)xb_add(&bar[XB_XCNT(b.x)], 1u);
    return b;
}
__device__ __forceinline__ void xcd_barrier_complete(unsigned* bar, unsigned x, unsigned& nloc, unsigned& nx) {
    const unsigned G = gridDim.x * gridDim.y * gridDim.z;
    unsigned sum, cnt, mine, sp = 0u;
    for (;;) {
        sum = 0u; cnt = 0u; mine = 0u;
#pragma unroll
        for (unsigned j = 0; j < 16; ++j) { const unsigned c = xb_ld(&bar[XB_XCNT(j)]); sum += c; cnt += (c > 0u) ? 1u : 0u; mine = (j == x) ? c : mine; }
        if (sum == G) break;
        __builtin_amdgcn_s_sleep(1);
        if ((++sp & 255u) == 0u) { if (xb_ld(&bar[XB_TMO])) break; if (sp > XB_SPIN_CAP) { atomicAdd(&bar[XB_TMO], 1u); break; } }
    }
    nloc = mine > 0u ? mine : 1u; nx = cnt > 0u ? cnt : 1u;
}
__device__ __forceinline__ void xcd_barrier(const XcdBarrier& b) {
    asm volatile("s_waitcnt vmcnt(0)" ::: "memory");
    __syncthreads();
    if (threadIdx.x == 0) {
        unsigned* bar = b.bar;
        __builtin_amdgcn_s_waitcnt(0);
        unsigned nloc = b.st[0], nx = b.st[1];
        if (nloc == 0u) { xcd_barrier_complete(bar, b.x, nloc, nx); b.st[0] = nloc; b.st[1] = nx; }
        const unsigned old = xb_add(&bar[XB_XSUB(b.x)], 1u);
        const unsigned gen = old / nloc;
        if (old + 1u == (gen + 1u) * nloc) {
            __builtin_amdgcn_fence(__ATOMIC_RELEASE, "agent");
            asm volatile("s_waitcnt vmcnt(0)" ::: "memory");
            const unsigned og = xb_add(&bar[XB_TOP], 1u);
            const unsigned tg = og / nx;
            if (og + 1u == (tg + 1u) * nx) xb_add(&bar[XB_TOPGEN], 1u);
            else XB_SPIN(xb_ld(&bar[XB_TOPGEN]) == tg, bar);
            __builtin_amdgcn_fence(__ATOMIC_ACQUIRE, "agent");
            xb_add(&bar[XB_XGEN(b.x)], 1u);
            asm volatile("s_waitcnt vmcnt(0)" ::: "memory");
        } else {
            XB_SPIN(xb_ld(&bar[XB_XGEN(b.x)]) == gen, bar);
            __builtin_amdgcn_fence(__ATOMIC_ACQUIRE, "agent");
            asm volatile("s_waitcnt vmcnt(0)" ::: "memory");
        }
    }
    __syncthreads();
}

struct Frame {
    LAS unsigned char* lds;
    float* sm;
    unsigned* ctl;
    int tid, lane, wave, G, bid;
    const float* in[35];
    float* out;
    unsigned char* ws;
};
enum { I_X = 0, I_P, I_LNEG, I_LNEB, I_WIN, I_MU, I_W0, I_WDEC, I_A0, I_WICLR, I_WGATE, I_KK, I_KA, I_RK, I_GNG, I_GNB, I_GLNG, I_GLNB, I_WSP, I_BSP,
       I_WOUT, I_LN1G, I_LN1B, I_WGR, I_BGR, I_WER, I_BER, I_WEG, I_WEU, I_WED, I_WPG, I_BPG, I_WPP, I_LN2G, I_LN2B };

template <class AF, class BF, class EF>
__device__ __forceinline__ void sgemm_tile(float* sA, float* sB, int tid, int m0, int n0, int K, AF af, BF bf, EF ef) {
    const int tx = tid & 15, ty = tid >> 4;
    float acc[4][4];
#pragma unroll
    for (int i = 0; i < 4; ++i)
#pragma unroll
        for (int j = 0; j < 4; ++j) acc[i][j] = 0.f;
    for (int k0 = 0; k0 < K; k0 += 16) {
        float ra[4], rb[2];
#pragma unroll
        for (int i = 0; i < 4; ++i) { const int idx = tid + i * 512, m = idx >> 4, k = idx & 15; ra[i] = af(m0 + m, k0 + k); }
#pragma unroll
        for (int i = 0; i < 2; ++i) { const int idx = tid + i * 512, k = idx >> 6, n = idx & 63; rb[i] = bf(k0 + k, n0 + n); }
        __syncthreads();
#pragma unroll
        for (int i = 0; i < 4; ++i) { const int idx = tid + i * 512, m = idx >> 4, k = idx & 15; sA[k * 132 + m] = ra[i]; }
#pragma unroll
        for (int i = 0; i < 2; ++i) { const int idx = tid + i * 512, k = idx >> 6, n = idx & 63; sB[k * 68 + n] = rb[i]; }
        __syncthreads();
#pragma unroll
        for (int k = 0; k < 16; ++k) {
            const float4 a = *(const float4*)(sA + k * 132 + ty * 4), b = *(const float4*)(sB + k * 68 + tx * 4);
            const float av[4] = {a.x, a.y, a.z, a.w}, bv[4] = {b.x, b.y, b.z, b.w};
#pragma unroll
            for (int i = 0; i < 4; ++i)
#pragma unroll
                for (int j = 0; j < 4; ++j) acc[i][j] = fmaf(av[i], bv[j], acc[i][j]);
        }
    }
    ef(m0 + ty * 4, n0 + tx * 4, acc);
    __syncthreads();
}

__device__ __forceinline__ void ph_ln0(Frame& F) {
    const float* x = F.in[I_X]; const float* g = F.in[I_LNEG]; const float* b = F.in[I_LNEB];
    bf16* XN = (bf16*)(F.ws + WS_XN); float* st = (float*)(F.ws + WS_STAT0);
    const int gw = F.bid * NWAVES + F.wave, NGW = F.G * NWAVES;
    for (int m = gw; m < T; m += NGW) {
        const float* xr = x + (size_t)m * D; float v[16]; float s = 0.f;
#pragma unroll
        for (int j = 0; j < 16; ++j) { v[j] = xr[F.lane + 64 * j]; s += v[j]; }
        const float mean = wave_sum(s) * (1.f / D); float q = 0.f;
#pragma unroll
        for (int j = 0; j < 16; ++j) { const float d = v[j] - mean; q += d * d; }
        const float rstd = 1.0f / sqrtf(wave_sum(q) * (1.f / D) + LN_EPS);
#pragma unroll
        for (int j = 0; j < 16; ++j) { const int c = F.lane + 64 * j; XN[(size_t)m * D + c] = f2bf((v[j] - mean) * rstd * g[c] + b[c]); }
        if (F.lane == 0) { st[2 * m] = mean; st[2 * m + 1] = rstd; }
    }
}
__device__ __forceinline__ void ph_proj(Frame& F) {
    const bf16* XN = (const bf16*)(F.ws + WS_XN); const float* W = F.in[I_WIN]; bf16* PR = (bf16*)(F.ws + WS_PROJ);
    float* sA = F.sm; float* sB = F.sm + 16 * 132;
    const int ntn = DIN / 64, ntm = T / 128;
    for (int tile = F.bid; tile < ntm * ntn; tile += F.G) {
        const int m0 = (tile / ntn) * 128, n0 = (tile % ntn) * 64;
        sgemm_tile(sA, sB, F.tid, m0, n0, D,
            [&](int m, int k) { return bf2f(XN[(size_t)m * D + k]); },
            [&](int k, int n) { return W[(size_t)k * DIN + n]; },
            [&](int mb, int nb, float (&acc)[4][4]) {
#pragma unroll
                for (int i = 0; i < 4; ++i)
#pragma unroll
                    for (int j = 0; j < 4; ++j) { float v = acc[i][j]; const int n = nb + j; if (n >= NSH) v = 0.5f * v * (1.0f + erff(v * 0.70710678f)); PR[(size_t)(mb + i) * DIN + n] = f2bf(v); }
            });
    }
}
__device__ __forceinline__ void ph_prep(Frame& F) {
    const bf16* PR = (const bf16*)(F.ws + WS_PROJ);
    const float* mu = F.in[I_MU]; const float* w0 = F.in[I_W0]; const float* Wd = F.in[I_WDEC]; const float* a0 = F.in[I_A0]; const float* Wa = F.in[I_WICLR]; const float* Wg = F.in[I_WGATE];
    const float* k_k = F.in[I_KK]; const float* k_a = F.in[I_KA];
    bf16* oR = (bf16*)(F.ws + WS_R); bf16* oK = (bf16*)(F.ws + WS_K); bf16* oV = (bf16*)(F.ws + WS_V); bf16* oKK = (bf16*)(F.ws + WS_KK); bf16* oKB = (bf16*)(F.ws + WS_KB);
    bf16* oLW = (bf16*)(F.ws + WS_LW); bf16* oG = (bf16*)(F.ws + WS_G);
    float* h = F.sm;
    const int c = F.tid;
    for (int t = F.bid; t < T; t += F.G) {
        __syncthreads();
        for (int cc = c; cc < NSH; cc += NTHR) {
            const float cur = bf2f(PR[(size_t)t * DIN + cc]);
            const float prev = (t % SEQ == 0) ? 0.f : bf2f(PR[(size_t)(t - 1) * DIN + cc]);
            float v = cur + (prev - cur) * mu[cc];
            if (cc >= 1536 && cc < 1600) v = tanhf(v);
            if (cc >= 1664) v = sigmoidf_(v);
            h[cc] = v;
        }
        __syncthreads();
        float d = w0[c], ai = a0[c], g = 0.f;
#pragma unroll 4
        for (int j = 0; j < 64; ++j) { d = fmaf(h[1536 + j], Wd[j * DR + c], d); ai = fmaf(h[1600 + j], Wa[j * DR + c], ai); }
#pragma unroll 4
        for (int j = 0; j < 128; ++j) g = fmaf(h[1664 + j], Wg[j * DR + c], g);
        const float lw = -DECAY_SCALE * sigmoidf_(d), ic = sigmoidf_(ai);
        const float k = h[512 + c]; float kk = k * k_k[c];
        const float nrm = sqrtf(wave_sum(kk * kk)); kk = kk / fmaxf(nrm, 1e-12f);
        const float kmod = k * (1.0f + (ic - 1.0f) * k_a[c]);
        const size_t o = (size_t)t * DR + c;
        oR[o] = f2bf(h[c]); oK[o] = f2bf(kmod); oV[o] = f2bf(h[1024 + c]); oKK[o] = f2bf(kk); oKB[o] = f2bf(kk * ic); oLW[o] = f2bf(lw); oG[o] = f2bf(g);
    }
    __syncthreads();
}
__device__ __forceinline__ void ph_zstat(Frame& F) {
    const bf16* PR = (const bf16*)(F.ws + WS_PROJ); float* zs = (float*)(F.ws + WS_ZSTAT);
    const int gw = F.bid * NWAVES + F.wave, NGW = F.G * NWAVES;
    for (int it = gw; it < T * GG; it += NGW) {
        const int t = it >> 2, g = it & 3; const bf16* p = PR + (size_t)t * DIN + NSH + DG + g * GW;
        const float a = bf2f(p[F.lane]), b = bf2f(p[F.lane + 64]);
        const float mean = wave_sum(a + b) * (1.f / GW); const float da = a - mean, db = b - mean;
        const float rstd = 1.0f / sqrtf(wave_sum(da * da + db * db) * (1.f / GW) + LN_EPS);
        if (F.lane == 0) { zs[2 * it] = mean; zs[2 * it + 1] = rstd; }
    }
}
__device__ __forceinline__ void ph_gmlp(Frame& F) {
    const bf16* PR = (const bf16*)(F.ws + WS_PROJ); const float* zs = (const float*)(F.ws + WS_ZSTAT);
    const float* lg = F.in[I_GLNG]; const float* lb = F.in[I_GLNB]; const float* wsp = F.in[I_WSP]; const float* bsp = F.in[I_BSP];
    bf16* CAT = (bf16*)(F.ws + WS_CAT);
    const int c = F.tid, g = c >> 7; const float gg = lg[c], gb = lb[c];
    for (int t = F.bid; t < T; t += F.G) {
        const int tl = t & (CH - 1), t0 = t - tl; const float* wrow = wsp + ((size_t)g * CH + tl) * CH;
        float acc = bsp[g * CH + tl];
        for (int sl = 0; sl <= tl; ++sl) {
            const int s = t0 + sl; const float zv = bf2f(PR[(size_t)s * DIN + NSH + DG + c]);
            const float zn = (zv - zs[(s * 4 + g) * 2]) * zs[(s * 4 + g) * 2 + 1] * gg + gb;
            acc = fmaf(wrow[sl], zn, acc);
        }
        const float zu = bf2f(PR[(size_t)t * DIN + NSH + c]);
        CAT[(size_t)t * D + DR + c] = f2bf(zu * acc);
    }
}
__device__ __forceinline__ void ph_wkv_naive(Frame& F) {
    const bf16* iR = (const bf16*)(F.ws + WS_R); const bf16* iK = (const bf16*)(F.ws + WS_K); const bf16* iV = (const bf16*)(F.ws + WS_V); const bf16* iKK = (const bf16*)(F.ws + WS_KK); const bf16* iKB = (const bf16*)(F.ws + WS_KB);
    const bf16* iLW = (const bf16*)(F.ws + WS_LW); const bf16* iG = (const bf16*)(F.ws + WS_G);
    const float* r_k = F.in[I_RK]; const float* gng = F.in[I_GNG]; const float* gnb = F.in[I_GNB];
    bf16* CAT = (bf16*)(F.ws + WS_CAT);
    if (F.wave != 0) return;
    float* sv = F.sm;
    for (int seq = F.bid; seq < BATCH * NH; seq += F.G) {
        const int b = seq / NH, hh = seq % NH; const int ch = hh * HD + F.lane;
        float st[64];
#pragma unroll
        for (int j = 0; j < 64; ++j) st[j] = 0.f;
        const float rk = r_k[ch], gg = gng[ch], gb = gnb[ch];
        for (int tb = 0; tb < SEQ; tb += 16) {
            for (int s = 0; s < 16; ++s) {
                const size_t o = (size_t)(b * SEQ + tb + s) * DR + ch;
                sv[(s * 5 + 0) * 64 + F.lane] = -bf2f(iKK[o]);
                sv[(s * 5 + 1) * 64 + F.lane] = __expf(bf2f(iLW[o]));
                sv[(s * 5 + 2) * 64 + F.lane] = bf2f(iKB[o]);
                sv[(s * 5 + 3) * 64 + F.lane] = bf2f(iK[o]);
                sv[(s * 5 + 4) * 64 + F.lane] = bf2f(iR[o]);
            }
            __builtin_amdgcn_s_waitcnt(0); __builtin_amdgcn_wave_barrier();
            for (int s = 0; s < 16; ++s) {
                const size_t o = (size_t)(b * SEQ + tb + s) * DR + ch;
                const float v = bf2f(iV[o]);
                const float* pa = sv + (s * 5 + 0) * 64; const float* pw = pa + 64; const float* pb = pa + 128; const float* pk = pa + 192; const float* pr = pa + 256;
                float sa = 0.f;
#pragma unroll
                for (int j = 0; j < 64; ++j) sa = fmaf(st[j], pa[j], sa);
                float y = 0.f;
#pragma unroll
                for (int j = 0; j < 64; ++j) { st[j] = fmaf(st[j], pw[j], fmaf(sa, pb[j], v * pk[j])); y = fmaf(st[j], pr[j], y); }
                const float m = wave_sum(y) * (1.f / 64.f); const float dy = y - m; const float var = wave_sum(dy * dy) * (1.f / 64.f);
                const float yn = dy * (1.0f / sqrtf(var + GN_EPS)) * gg + gb;
                const float bonus = wave_sum(pr[F.lane] * pk[F.lane] * rk) * v;
                CAT[(size_t)(b * SEQ + tb + s) * D + ch] = f2bf((yn + bonus) * bf2f(iG[o]));
            }
            __builtin_amdgcn_s_waitcnt(0); __builtin_amdgcn_wave_barrier();
        }
    }
}
__device__ __forceinline__ void ph_wout(Frame& F) {
    const bf16* CAT = (const bf16*)(F.ws + WS_CAT); const float* W = F.in[I_WOUT]; const float* x = F.in[I_X]; const float* st = (const float*)(F.ws + WS_STAT0);
    const float* g = F.in[I_LNEG]; const float* b = F.in[I_LNEB]; float* out = F.out;
    float* sA = F.sm; float* sB = F.sm + 16 * 132;
    const int ntn = D / 64, ntm = T / 128;
    for (int tile = F.bid; tile < ntm * ntn; tile += F.G) {
        const int m0 = (tile / ntn) * 128, n0 = (tile % ntn) * 64;
        sgemm_tile(sA, sB, F.tid, m0, n0, D,
            [&](int m, int k) { return bf2f(CAT[(size_t)m * D + k]); },
            [&](int k, int n) { return W[(size_t)k * D + n]; },
            [&](int mb, int nb, float (&acc)[4][4]) {
#pragma unroll
                for (int i = 0; i < 4; ++i) { const int m = mb + i; const float mean = st[2 * m], rstd = st[2 * m + 1];
#pragma unroll
                    for (int j = 0; j < 4; ++j) { const int n = nb + j; const float xn = (x[(size_t)m * D + n] - mean) * rstd * g[n] + b[n]; out[(size_t)m * D + n] = ALPHA * xn + acc[i][j]; } }
            });
    }
}
__device__ __forceinline__ void ph_rowln(Frame& F, const float* g, const float* b, bf16* xb) {
    float* out = F.out;
    const int gw = F.bid * NWAVES + F.wave, NGW = F.G * NWAVES;
    for (int m = gw; m < T; m += NGW) {
        float* xr = out + (size_t)m * D; float v[16]; float s = 0.f;
#pragma unroll
        for (int j = 0; j < 16; ++j) { v[j] = xr[F.lane + 64 * j]; s += v[j]; }
        const float mean = wave_sum(s) * (1.f / D); float q = 0.f;
#pragma unroll
        for (int j = 0; j < 16; ++j) { const float d = v[j] - mean; q += d * d; }
        const float rstd = 1.0f / sqrtf(wave_sum(q) * (1.f / D) + LN_EPS);
#pragma unroll
        for (int j = 0; j < 16; ++j) { const int c = F.lane + 64 * j; const float o = (v[j] - mean) * rstd * g[c] + b[c]; xr[c] = o; if (xb) xb[(size_t)m * D + c] = f2bf(o); }
    }
}
__device__ __forceinline__ void ph_route(Frame& F) {
    const float* x1 = F.out; const float* Wgr = F.in[I_WGR]; const float* bgr = F.in[I_BGR]; const float* Wer = F.in[I_WER]; const float* ber = F.in[I_BER];
    int* tokE = (int*)(F.ws + WS_TOKE); float* tokW = (float*)(F.ws + WS_TOKW); int* tokP = (int*)(F.ws + WS_TOKP); int* slotTok = (int*)(F.ws + WS_SLOTTOK);
    unsigned* ecnt = F.ctl + CW_ECNT;
    for (int i = F.bid * NTHR + F.tid; i < NSLOT; i += F.G * NTHR) slotTok[i] = -1;
    const int gw = F.bid * NWAVES + F.wave, NGW = F.G * NWAVES;
    for (int t = gw; t < T; t += NGW) {
        const float* xr = x1 + (size_t)t * D; float acc = 0.f; const int o = F.lane;
        if (o < 4) { for (int k = 0; k < D; ++k) acc = fmaf(xr[k], Wgr[k * 4 + o], acc); acc += bgr[o]; }
        else if (o < 36) { for (int k = 0; k < D; ++k) acc = fmaf(xr[k], Wer[k * 32 + (o - 4)], acc); acc += ber[o - 4]; }
        float gl[4];
#pragma unroll
        for (int j = 0; j < 4; ++j) gl[j] = __shfl(acc, j);
        int gs = 0; float gm = gl[0];
#pragma unroll
        for (int j = 1; j < 4; ++j) if (gl[j] > gm) { gm = gl[j]; gs = j; }
        float se = 0.f;
#pragma unroll
        for (int j = 0; j < 4; ++j) se += __expf(gl[j] - gm);
        const float pg = 1.0f / se;
        float el[8];
#pragma unroll
        for (int j = 0; j < 8; ++j) el[j] = __shfl(acc, 4 + gs * 8 + j);
        int i1 = 0; float v1 = el[0];
#pragma unroll
        for (int j = 1; j < 8; ++j) if (el[j] > v1) { v1 = el[j]; i1 = j; }
        int i2 = -1; float v2 = -3.0e38f;
#pragma unroll
        for (int j = 0; j < 8; ++j) if (j != i1 && el[j] > v2) { v2 = el[j]; i2 = j; }
        const float e2 = __expf(v2 - v1), w1 = pg / (1.0f + e2), w2 = pg * e2 / (1.0f + e2);
        if (F.lane == 0) {
            const int ea = gs * 8 + i1, eb = gs * 8 + i2;
            tokE[2 * t] = ea; tokE[2 * t + 1] = eb; tokW[2 * t] = w1; tokW[2 * t + 1] = w2;
            tokP[2 * t] = (int)atomicAdd(&ecnt[ea], 1u); tokP[2 * t + 1] = (int)atomicAdd(&ecnt[eb], 1u);
        }
    }
}
__device__ __forceinline__ void ph_bucket(Frame& F) {
    int* tokE = (int*)(F.ws + WS_TOKE); int* tokP = (int*)(F.ws + WS_TOKP); int* slotTok = (int*)(F.ws + WS_SLOTTOK); int* tileE = (int*)(F.ws + WS_TILEE);
    unsigned* ecnt = F.ctl + CW_ECNT;
    int* pstart = (int*)F.sm;
    __syncthreads();
    if (F.tid == 0) { int s = 0; for (int e = 0; e < NE; ++e) { pstart[e] = s; s += (((int)xb_ld(&ecnt[e]) + 255) / 256) * 256; } pstart[NE] = s; }
    __syncthreads();
    if (F.bid == 0 && F.tid == 0) __hip_atomic_store(F.ctl + CW_NTILES, (unsigned)(pstart[NE] / 256), RLX_AGENT);
    if (F.bid == 0) for (int tl = F.tid; tl < NTILE256; tl += NTHR) { int e = -1; for (int j = 0; j < NE; ++j) if (tl * 256 >= pstart[j] && tl * 256 < pstart[j + 1]) e = j; tileE[tl] = e; }
    for (int i = F.bid * NTHR + F.tid; i < 2 * T; i += F.G * NTHR) { const int slot = pstart[tokE[i]] + tokP[i]; tokP[i] = slot; slotTok[slot] = i >> 1; }
    __syncthreads();
}
__device__ __forceinline__ void ph_up(Frame& F) {
    const bf16* X1B = (const bf16*)(F.ws + WS_X1B); const float* Weg = F.in[I_WEG]; const float* Weu = F.in[I_WEU]; bf16* HID = (bf16*)(F.ws + WS_HID);
    const int* slotTok = (const int*)(F.ws + WS_SLOTTOK); const int* tileE = (const int*)(F.ws + WS_TILEE);
    float* sA = F.sm; float* sB = F.sm + 16 * 132;
    const int ntn = (2 * DE) / 64, ntm = NSLOT / 128;
    for (int tile = F.bid; tile < ntm * ntn; tile += F.G) {
        const int m0 = (tile / ntn) * 128, n0 = (tile % ntn) * 64; const int e = tileE[m0 >> 8];
        if (e < 0) continue;
        const float* wg = Weg + (size_t)e * D * DE; const float* wu = Weu + (size_t)e * D * DE;
        sgemm_tile(sA, sB, F.tid, m0, n0, D,
            [&](int m, int k) { const int tk = slotTok[m]; return tk >= 0 ? bf2f(X1B[(size_t)tk * D + k]) : 0.f; },
            [&](int k, int n) { return (n & 1) ? wu[(size_t)k * DE + (n >> 1)] : wg[(size_t)k * DE + (n >> 1)]; },
            [&](int mb, int nb, float (&acc)[4][4]) {
#pragma unroll
                for (int i = 0; i < 4; ++i)
#pragma unroll
                    for (int j = 0; j < 2; ++j) { const float gt = acc[i][2 * j], up = acc[i][2 * j + 1]; HID[(size_t)(mb + i) * DE + (nb >> 1) + j] = f2bf(gt * sigmoidf_(gt) * up); }
            });
    }
}
__device__ __forceinline__ void ph_down(Frame& F) {
    const bf16* HID = (const bf16*)(F.ws + WS_HID); const float* Wed = F.in[I_WED]; bf16* Y = (bf16*)(F.ws + WS_Y);
    const int* tileE = (const int*)(F.ws + WS_TILEE);
    float* sA = F.sm; float* sB = F.sm + 16 * 132;
    const int ntn = D / 64, ntm = NSLOT / 128;
    for (int tile = F.bid; tile < ntm * ntn; tile += F.G) {
        const int m0 = (tile / ntn) * 128, n0 = (tile % ntn) * 64; const int e = tileE[m0 >> 8];
        if (e < 0) continue;
        const float* wd = Wed + (size_t)e * DE * D;
        sgemm_tile(sA, sB, F.tid, m0, n0, DE,
            [&](int m, int k) { return bf2f(HID[(size_t)m * DE + k]); },
            [&](int k, int n) { return wd[(size_t)k * D + n]; },
            [&](int mb, int nb, float (&acc)[4][4]) {
#pragma unroll
                for (int i = 0; i < 4; ++i)
#pragma unroll
                    for (int j = 0; j < 4; ++j) Y[(size_t)(mb + i) * D + nb + j] = f2bf(acc[i][j]);
            });
    }
}
__device__ __forceinline__ void ph_pproj(Frame& F) {
    const float* P = F.in[I_P]; const float* W = F.in[I_WPP]; bf16* PP = (bf16*)(F.ws + WS_PP);
    float* sA = F.sm; float* sB = F.sm + 16 * 132;
    const int ntn = D / 64, ntm = T / 128;
    for (int tile = F.bid; tile < ntm * ntn; tile += F.G) {
        const int m0 = (tile / ntn) * 128, n0 = (tile % ntn) * 64;
        sgemm_tile(sA, sB, F.tid, m0, n0, DP,
            [&](int m, int k) { return P[(size_t)m * DP + k]; },
            [&](int k, int n) { return W[(size_t)k * D + n]; },
            [&](int mb, int nb, float (&acc)[4][4]) {
#pragma unroll
                for (int i = 0; i < 4; ++i)
#pragma unroll
                    for (int j = 0; j < 4; ++j) PP[(size_t)(mb + i) * D + nb + j] = f2bf(acc[i][j]);
            });
    }
}
__device__ __forceinline__ void ph_gate(Frame& F) {
    const bf16* X1B = (const bf16*)(F.ws + WS_X1B); const float* W = F.in[I_WPG]; const float* bpg = F.in[I_BPG]; const bf16* PP = (const bf16*)(F.ws + WS_PP); const bf16* Y = (const bf16*)(F.ws + WS_Y);
    const int* tokP = (const int*)(F.ws + WS_TOKP); const float* tokW = (const float*)(F.ws + WS_TOKW); float* out = F.out;
    float* sA = F.sm; float* sB = F.sm + 16 * 132;
    const int ntn = D / 64, ntm = T / 128;
    for (int tile = F.bid; tile < ntm * ntn; tile += F.G) {
        const int m0 = (tile / ntn) * 128, n0 = (tile % ntn) * 64;
        sgemm_tile(sA, sB, F.tid, m0, n0, D,
            [&](int m, int k) { return bf2f(X1B[(size_t)m * D + k]); },
            [&](int k, int n) { return W[(size_t)k * D + n]; },
            [&](int mb, int nb, float (&acc)[4][4]) {
#pragma unroll
                for (int i = 0; i < 4; ++i) { const int m = mb + i; const int s0 = tokP[2 * m], s1 = tokP[2 * m + 1]; const float w0 = tokW[2 * m], w1 = tokW[2 * m + 1];
#pragma unroll
                    for (int j = 0; j < 4; ++j) { const int n = nb + j; const size_t o = (size_t)m * D + n;
                        const float ffn = w0 * bf2f(Y[(size_t)s0 * D + n]) + w1 * bf2f(Y[(size_t)s1 * D + n]);
                        out[o] = ALPHA * out[o] + ffn + sigmoidf_(acc[i][j] + bpg[n]) * bf2f(PP[o]); } }
            });
    }
}


namespace pg8 {
#define PG8_LAS __attribute__((address_space(3)))
typedef unsigned short bf16_t;
typedef short bf16x8 __attribute__((ext_vector_type(8)));
typedef float f32x4 __attribute__((ext_vector_type(4)));
typedef float f32x2 __attribute__((ext_vector_type(2)));
typedef unsigned u32x4 __attribute__((ext_vector_type(4)));
typedef unsigned u32x2 __attribute__((ext_vector_type(2)));
constexpr int BM = 256, BK = 64, HALF = 128, HTB = HALF * BK * 2, STAGE_BYTES = 8 * HTB, NXCD = 8, WGM = 8;
__host__ __device__ __forceinline__ int lds_byte(int r, int c) { const int st = (r >> 4) * 2 + (c >> 5), rr = r & 15, cc = c & 31, ob = rr * 64 + cc * 2; return st * 1024 + (ob ^ (((ob >> 9) & 1) << 5)); }
__host__ __device__ __forceinline__ void stage_rc(int b, int& R, int& C) { const int st = b / 1024, sb = b % 1024, swz = sb ^ (((sb >> 9) & 1) << 5); R = (st >> 1) * 16 + swz / 64; C = (st & 1) * 32 + (swz % 64) / 2; }
__host__ __device__ __forceinline__ int perm32(int rho) { const int n = rho >> 4, i = rho & 15; return 8 * (i >> 2) + 4 * n + (i & 3); }
struct Unit { int pm, pn; };

struct OrdStd {
    const char* A; const char* Bt; int K; int nM, nN, nwg, G, c;
    __device__ __forceinline__ void init(const void* A_, const void* Bt_, int M, int N, int K_, int G_, int c_) { A = (const char*)A_; Bt = (const char*)Bt_; K = K_; nM = M / BM; nN = N / BM; nwg = nM * nN; G = G_; c = c_; }
    __device__ __forceinline__ bool next(int i, Unit& u) const {
        const long L = (long)i * G + c; if (L >= nwg) return false;
        int wgid = (int)L; { const int q = nwg / NXCD, r = nwg % NXCD, xcd = wgid % NXCD, off = wgid / NXCD; wgid = (xcd < r ? xcd * (q + 1) : r * (q + 1) + (xcd - r) * q) + off; }
        const int nig = WGM * nN, gid = wgid / nig, fm = gid * WGM, gsz = (nM - fm) < WGM ? (nM - fm) : WGM;
        u.pm = fm + ((wgid % nig) % gsz); u.pn = (wgid % nig) / gsz; return true;
    }
    __device__ __forceinline__ const char* a_ptr(const Unit& u) const { return A + (size_t)u.pm * BM * K * 2; }
    __device__ __forceinline__ const char* b_ptr(const Unit& u) const { return Bt + (size_t)u.pn * BM * K * 2; }
    __device__ __forceinline__ void a_off(const Unit&, const int (&R)[2], const int (&C)[2], unsigned (&v)[2][2]) const {
#pragma unroll
        for (int h = 0; h < 2; ++h)
#pragma unroll
            for (int i = 0; i < 2; ++i) v[h][i] = (unsigned)((R[i] + HALF * h) * K + C[i]) * 2u;
    }
};
template <bool GATHER> struct OrdExp {
    const char* A; const char* Bt; int K; const int* slotTok; const int* tileE; int ntiles, G, c; size_t estride;
    __device__ __forceinline__ bool next(int i, Unit& u) const { const int L = i * G + c; if (L >= ntiles * 4) return false; u.pm = L >> 2; u.pn = L & 3; return true; }
    __device__ __forceinline__ const char* a_ptr(const Unit& u) const { return GATHER ? A : A + (size_t)u.pm * BM * K * 2; }
    __device__ __forceinline__ const char* b_ptr(const Unit& u) const { const int e = tileE[u.pm]; return Bt + (size_t)e * estride + (size_t)u.pn * BM * K * 2; }
    __device__ __forceinline__ void a_off(const Unit& u, const int (&R)[2], const int (&C)[2], unsigned (&v)[2][2]) const {
#pragma unroll
        for (int h = 0; h < 2; ++h)
#pragma unroll
            for (int i = 0; i < 2; ++i) {
                int row = R[i] + HALF * h;
                if (GATHER) { row = slotTok[u.pm * BM + row]; row = row < 0 ? 0 : row; }
                v[h][i] = (unsigned)(row * K + C[i]) * 2u;
            }
    }
};

__device__ __forceinline__ unsigned cvt_pk_bf16(float lo, float hi) { unsigned r; asm volatile("v_cvt_pk_bf16_f32 %0, %1, %2" : "=v"(r) : "v"(lo), "v"(hi)); return r; }
__device__ __forceinline__ f32x2 gelu_pk(f32x2 v) {
    const f32x2 av = __builtin_elementwise_abs(v), d = av * 0.2316418882f + 1.0f;
    f32x2 t; t.x = __builtin_amdgcn_rcpf(d.x); t.y = __builtin_amdgcn_rcpf(d.y);
    f32x2 q = t * 0.5307027145f + (-0.7265760135f); q = q * t + 0.7107068705f; q = q * t + (-0.142248368f); q = q * t + 0.127414796f; q = q * t;
    const f32x2 s = (v * v) * (-0.72134752044f);
    f32x2 e; e.x = __builtin_amdgcn_exp2f(s.x); e.y = __builtin_amdgcn_exp2f(s.y);
    const f32x2 m = v * (q * e), r = v - m;
    f32x2 o; o.x = v.x < 0.f ? m.x : r.x; o.y = v.y < 0.f ? m.y : r.y; return o;
}
__device__ __forceinline__ float bfl(unsigned w) { return __uint_as_float(w << 16); }
__device__ __forceinline__ float bfh(unsigned w) { return __uint_as_float(w & 0xffff0000u); }
__device__ __forceinline__ float sigm(float x) { return __builtin_amdgcn_rcpf(1.0f + __expf(-x)); }

struct EpiBf16 {
    static constexpr bool PERM = true;
    bf16_t* O; int ldc; int gelu_from_pn;
    __device__ __forceinline__ void operator()(const f32x4 (&acc)[2][2][4][2], const Unit& u, int wr, int wc, int fr, int fq) const {
        const int row0 = u.pm * BM + wr * 64 + fr, col0 = u.pn * BM + wc * 32 + 8 * fq; const bool act = u.pn >= gelu_from_pn;
#pragma unroll
        for (int ai = 0; ai < 2; ++ai)
#pragma unroll
            for (int m = 0; m < 4; ++m) { bf16_t* rowp = O + (size_t)(row0 + ai * HALF + m * 16) * ldc + col0;
#pragma unroll
                for (int bj = 0; bj < 2; ++bj) { f32x4 v0 = acc[ai][bj][m][0], v1 = acc[ai][bj][m][1];
                    if (act) { f32x2 a = gelu_pk((f32x2){v0[0], v0[1]}), b = gelu_pk((f32x2){v0[2], v0[3]}), c = gelu_pk((f32x2){v1[0], v1[1]}), d = gelu_pk((f32x2){v1[2], v1[3]});
                        v0 = (f32x4){a.x, a.y, b.x, b.y}; v1 = (f32x4){c.x, c.y, d.x, d.y}; }
                    u32x4 w; w.x = cvt_pk_bf16(v0[0], v0[1]); w.y = cvt_pk_bf16(v0[2], v0[3]); w.z = cvt_pk_bf16(v1[0], v1[1]); w.w = cvt_pk_bf16(v1[2], v1[3]);
                    *(u32x4*)(rowp + bj * HALF) = w; } }
    }
};
struct EpiUp {
    static constexpr bool PERM = true;
    bf16_t* HIDp;
    __device__ __forceinline__ void operator()(const f32x4 (&acc)[2][2][4][2], const Unit& u, int wr, int wc, int fr, int fq) const {
        const int row0 = u.pm * BM + wr * 64 + fr, hcol0 = u.pn * 128 + wc * 16 + 4 * fq;
#pragma unroll
        for (int ai = 0; ai < 2; ++ai)
#pragma unroll
            for (int m = 0; m < 4; ++m) { bf16_t* rowp = HIDp + (size_t)(row0 + ai * HALF + m * 16) * DE + hcol0;
#pragma unroll
                for (int bj = 0; bj < 2; ++bj) { const f32x4 v0 = acc[ai][bj][m][0], v1 = acc[ai][bj][m][1];
                    const float h0 = v0[0] * sigm(v0[0]) * v0[1], h1 = v0[2] * sigm(v0[2]) * v0[3], h2 = v1[0] * sigm(v1[0]) * v1[1], h3 = v1[2] * sigm(v1[2]) * v1[3];
                    u32x2 w; w.x = cvt_pk_bf16(h0, h1); w.y = cvt_pk_bf16(h2, h3);
                    *(u32x2*)(rowp + bj * 64) = w; } }
    }
};
struct EpiWout {
    static constexpr bool PERM = false;
    const float* x; const float* st; const float* g; const float* b; float* out;
    __device__ __forceinline__ void operator()(const f32x4 (&acc)[2][2][4][2], const Unit& u, int wr, int wc, int fr, int fq) const {
        const int col0 = u.pn * BM + wc * 32 + 4 * fq;
        f32x4 gv[2][2], bv[2][2];
#pragma unroll
        for (int bj = 0; bj < 2; ++bj)
#pragma unroll
            for (int n = 0; n < 2; ++n) { gv[bj][n] = *(const f32x4*)(g + col0 + bj * HALF + n * 16); bv[bj][n] = *(const f32x4*)(b + col0 + bj * HALF + n * 16); }
#pragma unroll
        for (int ai = 0; ai < 2; ++ai)
#pragma unroll
            for (int m = 0; m < 4; ++m) { const int row = u.pm * BM + ai * HALF + wr * 64 + m * 16 + fr; const float mean = st[2 * row], rstd = st[2 * row + 1]; const size_t off = (size_t)row * D + col0;
#pragma unroll
                for (int bj = 0; bj < 2; ++bj)
#pragma unroll
                    for (int n = 0; n < 2; ++n) { const f32x4 xv = *(const f32x4*)(x + off + bj * HALF + n * 16);
                        *(f32x4*)(out + off + bj * HALF + n * 16) = ((xv - mean) * rstd * gv[bj][n] + bv[bj][n]) * ALPHA + acc[ai][bj][m][n]; }
                asm volatile("" ::: "memory"); }
    }
};
struct EpiGate {
    static constexpr bool PERM = false;
    float* out; const bf16_t* Y; const bf16_t* PP; const float* bias; const int* tokP; const float* tokW;
    __device__ __forceinline__ void operator()(const f32x4 (&acc)[2][2][4][2], const Unit& u, int wr, int wc, int fr, int fq) const {
        const int col0 = u.pn * BM + wc * 32 + 4 * fq;
        f32x4 bv[2][2];
#pragma unroll
        for (int bj = 0; bj < 2; ++bj)
#pragma unroll
            for (int n = 0; n < 2; ++n) bv[bj][n] = *(const f32x4*)(bias + col0 + bj * HALF + n * 16);
#pragma unroll
        for (int ai = 0; ai < 2; ++ai)
#pragma unroll
            for (int m = 0; m < 4; ++m) { const int row = u.pm * BM + ai * HALF + wr * 64 + m * 16 + fr; const size_t off = (size_t)row * D + col0;
                const int s0 = tokP[2 * row], s1 = tokP[2 * row + 1]; const float w0 = tokW[2 * row], w1 = tokW[2 * row + 1];
                const bf16_t* y0p = Y + (size_t)s0 * D + col0; const bf16_t* y1p = Y + (size_t)s1 * D + col0;
#pragma unroll
                for (int bj = 0; bj < 2; ++bj)
#pragma unroll
                    for (int n = 0; n < 2; ++n) { const int co = bj * HALF + n * 16;
                        const f32x4 xv = *(const f32x4*)(out + off + co); const u32x2 ya = *(const u32x2*)(y0p + co), yb = *(const u32x2*)(y1p + co), pp = *(const u32x2*)(PP + off + co);
                        const f32x4 a = acc[ai][bj][m][n] + bv[bj][n];
                        f32x4 o;
                        o[0] = ALPHA * xv[0] + w0 * bfl(ya.x) + w1 * bfl(yb.x) + sigm(a[0]) * bfl(pp.x);
                        o[1] = ALPHA * xv[1] + w0 * bfh(ya.x) + w1 * bfh(yb.x) + sigm(a[1]) * bfh(pp.x);
                        o[2] = ALPHA * xv[2] + w0 * bfl(ya.y) + w1 * bfl(yb.y) + sigm(a[2]) * bfl(pp.y);
                        o[3] = ALPHA * xv[3] + w0 * bfh(ya.y) + w1 * bfh(yb.y) + sigm(a[3]) * bfh(pp.y);
                        *(f32x4*)(out + off + co) = o; }
                asm volatile("" ::: "memory"); }
    }
};

template <class Epi, class Sched, bool ALIGN_EPI>
__device__ __forceinline__ void gemm_phase(PG8_LAS unsigned char* lds, const int K, const Sched& S, const Epi& E) {
    const int tid = threadIdx.x, wid = __builtin_amdgcn_readfirstlane(tid >> 6), lane = tid & 63, wr = wid >> 2, wc = wid & 3, fr = lane & 15, fq = lane >> 4;
    const int nt = K / BK;
    unsigned voffB[2]; int Rr[2], Cc[2];
#pragma unroll
    for (int i = 0; i < 2; ++i) { int R, C; stage_rc(tid * 16 + i * 8192, R, C); const int Rb = Epi::PERM ? ((R & ~31) + perm32(R & 31)) : R; Rr[i] = R; Cc[i] = C; voffB[i] = (unsigned)(Rb * K + C) * 2u; }
    const size_t kstep = (size_t)(BK * 2);
    const size_t hstep = (size_t)HALF * K * 2;
    const unsigned ldsw = (unsigned)wid * 1024u;
    const int aoff = lds_byte(wr * 64 + fr, fq * 8), boff = lds_byte(wc * 32 + fr, fq * 8);
#define PG8_SA(b, h) (((b) * 2 + (h)) * HTB)
#define PG8_SB(b, h) ((4 + (b) * 2 + (h)) * HTB)
#define PG8_STAGE(bufoff, gbase, voff) do { _Pragma("unroll") for (int _i = 0; _i < 2; ++_i) \
        __builtin_amdgcn_global_load_lds((const unsigned*)((const char*)(gbase) + (voff)[_i]), (PG8_LAS unsigned*)(lds + (bufoff) + ldsw + _i * 8192), 16, 0, 0); } while (0)
#define PG8_LDA(dst, b, h) do { _Pragma("unroll") for (int m = 0; m < 4; ++m) _Pragma("unroll") for (int k = 0; k < 2; ++k) dst[m][k] = *(const PG8_LAS bf16x8*)(lds + PG8_SA(b, h) + aoff + m * 2048 + k * 1024); } while (0)
#define PG8_LDB(dst, b, h) do { _Pragma("unroll") for (int n = 0; n < 2; ++n) _Pragma("unroll") for (int k = 0; k < 2; ++k) dst[n][k] = *(const PG8_LAS bf16x8*)(lds + PG8_SB(b, h) + boff + n * 2048 + k * 1024); } while (0)
#define PG8_MMA(ai, bj, At, Bt) do { __builtin_amdgcn_s_setprio(1); _Pragma("unroll") for (int m = 0; m < 4; ++m) _Pragma("unroll") for (int n = 0; n < 2; ++n) _Pragma("unroll") for (int k = 0; k < 2; ++k) \
        acc[ai][bj][m][n] = __builtin_amdgcn_mfma_f32_16x16x32_bf16(Bt[n][k], At[m][k], acc[ai][bj][m][n], 0, 0, 0); __builtin_amdgcn_s_setprio(0); } while (0)
#define PG8_WAIT_V(n) asm volatile("s_waitcnt vmcnt(" #n ")" ::: "memory")
#define PG8_WAIT_L(n) asm volatile("s_waitcnt lgkmcnt(" #n ")" ::: "memory")
#define PG8_BAR __builtin_amdgcn_s_barrier()
#define PG8_SCHED __builtin_amdgcn_sched_barrier(0)
    Unit cur, nxt; int ui = 0;
    if (!S.next(0, cur)) return;
    f32x4 acc[2][2][4][2];
#pragma unroll
    for (int a = 0; a < 2; ++a)
#pragma unroll
        for (int b = 0; b < 2; ++b)
#pragma unroll
            for (int m = 0; m < 4; ++m)
#pragma unroll
                for (int n = 0; n < 2; ++n) acc[a][b][m][n] = (f32x4){0.f, 0.f, 0.f, 0.f};
    bf16x8 At[4][2], B0[2][2], B1[2][2];
    unsigned vAc[2][2], vAn[2][2];
    S.a_off(cur, Rr, Cc, vAc);
    const char* cA = S.a_ptr(cur); const char* cB = S.b_ptr(cur);
    PG8_STAGE(PG8_SB(0, 0), cB, voffB); PG8_STAGE(PG8_SB(0, 1), cB + hstep, voffB); PG8_STAGE(PG8_SA(0, 0), cA, vAc[0]); PG8_STAGE(PG8_SA(0, 1), cA, vAc[1]);
    if (wr == 1) PG8_BAR;
    PG8_WAIT_V(2); PG8_BAR;
    PG8_STAGE(PG8_SB(1, 0), cB + kstep, voffB); PG8_STAGE(PG8_SA(1, 0), cA + kstep, vAc[0]); PG8_STAGE(PG8_SB(1, 1), cB + hstep + kstep, voffB);
    PG8_WAIT_V(6); PG8_BAR;
    for (;;) {
        const bool has_next = S.next(ui + 1, nxt);
        const char* nA = cA; const char* nB = cB;
#pragma unroll
        for (int h = 0; h < 2; ++h)
#pragma unroll
            for (int i = 0; i < 2; ++i) vAn[h][i] = vAc[h][i];
        if (has_next) { nA = S.a_ptr(nxt); nB = S.b_ptr(nxt); S.a_off(nxt, Rr, Cc, vAn); }
        for (int t = 0; t < nt; t += 2) {
            const bool last = (t == nt - 2);
            const char* a1 = cA + (size_t)(t + 1) * kstep;
            const char* a2 = last ? nA : cA + (size_t)(t + 2) * kstep; const char* b2 = last ? nB : cB + (size_t)(t + 2) * kstep;
            const char* a3 = a2 + kstep; const char* b3 = b2 + kstep;
            unsigned s0[2], s1[2];
#pragma unroll
            for (int i = 0; i < 2; ++i) { s0[i] = last ? vAn[0][i] : vAc[0][i]; s1[i] = last ? vAn[1][i] : vAc[1][i]; }
            PG8_LDB(B0, 0, 0); PG8_LDB(B1, 0, 1); PG8_SCHED; PG8_LDA(At, 0, 0); PG8_STAGE(PG8_SA(1, 1), a1, vAc[1]);
            PG8_WAIT_V(8); PG8_WAIT_L(0); PG8_BAR; PG8_MMA(0, 0, At, B0); PG8_MMA(0, 1, At, B1); PG8_BAR; PG8_SCHED;
            PG8_LDA(At, 0, 1); PG8_STAGE(PG8_SB(0, 0), b2, voffB); PG8_STAGE(PG8_SB(0, 1), b2 + hstep, voffB); PG8_STAGE(PG8_SA(0, 0), a2, s0);
            PG8_WAIT_V(8); PG8_WAIT_L(0); PG8_BAR; PG8_MMA(1, 0, At, B0); PG8_MMA(1, 1, At, B1); PG8_BAR; PG8_SCHED;
            PG8_LDB(B0, 1, 0); PG8_LDB(B1, 1, 1); PG8_SCHED; PG8_LDA(At, 1, 0); PG8_STAGE(PG8_SA(0, 1), a2, s1);
            PG8_WAIT_V(8); PG8_WAIT_L(0); PG8_BAR; PG8_MMA(0, 0, At, B0); PG8_MMA(0, 1, At, B1); PG8_BAR; PG8_SCHED;
            PG8_LDA(At, 1, 1); PG8_STAGE(PG8_SB(1, 0), b3, voffB); PG8_STAGE(PG8_SB(1, 1), b3 + hstep, voffB); PG8_STAGE(PG8_SA(1, 0), a3, s0);
            PG8_WAIT_V(8); PG8_WAIT_L(0); PG8_BAR; PG8_MMA(1, 0, At, B0); PG8_MMA(1, 1, At, B1); PG8_BAR; PG8_SCHED;
        }
        if constexpr (ALIGN_EPI) { if (wr == 0) PG8_BAR; }
        E(acc, cur, wr, wc, fr, fq);
        if (!has_next) break;
#pragma unroll
        for (int a = 0; a < 2; ++a)
#pragma unroll
            for (int b = 0; b < 2; ++b)
#pragma unroll
                for (int m = 0; m < 4; ++m)
#pragma unroll
                    for (int n = 0; n < 2; ++n) acc[a][b][m][n] = (f32x4){0.f, 0.f, 0.f, 0.f};
        cur = nxt; cA = nA; cB = nB; ++ui;
#pragma unroll
        for (int h = 0; h < 2; ++h)
#pragma unroll
            for (int i = 0; i < 2; ++i) vAc[h][i] = vAn[h][i];
        if constexpr (ALIGN_EPI) { if (wr == 1) PG8_BAR; }
    }
    PG8_WAIT_V(0);
    if constexpr (!ALIGN_EPI) { if (wr == 0) PG8_BAR; }
    PG8_BAR;
#undef PG8_SA
#undef PG8_SB
#undef PG8_STAGE
#undef PG8_LDA
#undef PG8_LDB
#undef PG8_MMA
#undef PG8_WAIT_V
#undef PG8_WAIT_L
#undef PG8_BAR
#undef PG8_SCHED
}
}

__device__ __forceinline__ unsigned pk2(float lo, float hi) { return (unsigned)f2bf(lo) | ((unsigned)f2bf(hi) << 16); }
typedef unsigned v4u __attribute__((ext_vector_type(4)));
__device__ __forceinline__ void transpose_item(const float* W, int K, int N, bf16* WT, int row_off, int row_mul, LAS float* scr, int item, int lane) {
    const int nblk = N / 32, kb = item / nblk, nb = item % nblk, k0 = 64 * kb, n0 = 32 * nb;
#pragma unroll 8
    for (int i = 0; i < 32; ++i) { const int kk = 2 * i + (lane >> 5); scr[kk * 33 + (lane & 31)] = W[(size_t)(k0 + kk) * N + n0 + (lane & 31)]; }
    asm volatile("s_waitcnt lgkmcnt(0)" ::: "memory");
    const int c = lane & 7;
#pragma unroll
    for (int j = 0; j < 4; ++j) { const int n = (lane >> 3) + 8 * j; const LAS float* s = scr + (8 * c) * 33 + n;
        v4u o; o.x = pk2(s[0 * 33], s[1 * 33]); o.y = pk2(s[2 * 33], s[3 * 33]); o.z = pk2(s[4 * 33], s[5 * 33]); o.w = pk2(s[6 * 33], s[7 * 33]);
        *(GAS v4u*)(WT + (size_t)(row_off + row_mul * (n0 + n)) * K + k0 + 8 * c) = o; }
    asm volatile("s_waitcnt lgkmcnt(0)" ::: "memory");
}
__device__ __forceinline__ void ph_wconv_small(Frame& F) {
    LAS float* scr = (LAS float*)(F.lds + F.wave * 16384);
    const int gw = F.bid * NWAVES + F.wave, NGW = F.G * NWAVES;
    constexpr int I_IN = (D / 64) * (DIN / 32), I_O = (D / 64) * (D / 32), I_PP = (DP / 64) * (D / 32);
    constexpr int NIT = I_IN + 2 * I_O + I_PP;
    for (int it = gw; it < NIT; it += NGW) {
        int r = it;
        if (r < I_IN) { transpose_item(F.in[I_WIN], D, DIN, (bf16*)(F.ws + WS_WIN_T), 0, 1, scr, r, F.lane); continue; } r -= I_IN;
        if (r < I_O) { transpose_item(F.in[I_WOUT], D, D, (bf16*)(F.ws + WS_WOUT_T), 0, 1, scr, r, F.lane); continue; } r -= I_O;
        if (r < I_O) { transpose_item(F.in[I_WPG], D, D, (bf16*)(F.ws + WS_WPG_T), 0, 1, scr, r, F.lane); continue; } r -= I_O;
        transpose_item(F.in[I_WPP], DP, D, (bf16*)(F.ws + WS_WPP_T), 0, 1, scr, r, F.lane);
    }
}
__device__ __forceinline__ void ph_wconv_exp(Frame& F) {
    LAS float* scr = (LAS float*)(F.lds + F.wave * 16384);
    const int gw = F.bid * NWAVES + F.wave, NGW = F.G * NWAVES;
    constexpr int I_G = (D / 64) * (DE / 32), I_D = (DE / 64) * (D / 32), PER_E = 2 * I_G + I_D;
    for (int it = gw; it < NE * PER_E; it += NGW) {
        const int e = it / PER_E; int r = it % PER_E;
        bf16* gu = (bf16*)(F.ws + WS_WGU_T) + (size_t)e * (2 * DE) * D; bf16* dn = (bf16*)(F.ws + WS_WD_T) + (size_t)e * D * DE;
        if (r < I_G) { transpose_item(F.in[I_WEG] + (size_t)e * D * DE, D, DE, gu, 0, 2, scr, r, F.lane); continue; } r -= I_G;
        if (r < I_G) { transpose_item(F.in[I_WEU] + (size_t)e * D * DE, D, DE, gu, 1, 2, scr, r, F.lane); continue; } r -= I_G;
        transpose_item(F.in[I_WED] + (size_t)e * DE * D, DE, D, dn, 0, 1, scr, r, F.lane);
    }
    const float4* p4 = (const float4*)F.in[I_P]; uint2* pb = (uint2*)(F.ws + WS_PB);
    for (size_t i = (size_t)F.bid * NTHR + F.tid; i < (size_t)T * DP / 4; i += (size_t)F.G * NTHR) { const float4 v = p4[i]; uint2 o; o.x = pk2(v.x, v.y); o.y = pk2(v.z, v.w); pb[i] = o; }
}
__device__ __forceinline__ void ph_proj_fast(Frame& F) {
    pg8::OrdStd S; S.init(F.ws + WS_XN, F.ws + WS_WIN_T, T, DIN, D, F.G, F.bid);
    pg8::EpiBf16 E{(bf16*)(F.ws + WS_PROJ), DIN, NSH / 256};
    pg8::gemm_phase<pg8::EpiBf16, pg8::OrdStd, true>(F.lds, D, S, E);
}
__device__ __forceinline__ void ph_wout_fast(Frame& F) {
    pg8::OrdStd S; S.init(F.ws + WS_CAT, F.ws + WS_WOUT_T, T, D, D, F.G, F.bid);
    pg8::EpiWout E{F.in[I_X], (const float*)(F.ws + WS_STAT0), F.in[I_LNEG], F.in[I_LNEB], F.out};
    pg8::gemm_phase<pg8::EpiWout, pg8::OrdStd, true>(F.lds, D, S, E);
}
__device__ __forceinline__ void ph_up_fast(Frame& F) {
    const int nt = (int)xb_ld(F.ctl + CW_NTILES);
    pg8::OrdExp<true> S{(const char*)(F.ws + WS_X1B), (const char*)(F.ws + WS_WGU_T), D, (const int*)(F.ws + WS_SLOTTOK), (const int*)(F.ws + WS_TILEE), nt, F.G, F.bid, (size_t)(2 * DE) * D * 2};
    pg8::EpiUp E{(bf16*)(F.ws + WS_HID)};
    pg8::gemm_phase<pg8::EpiUp, pg8::OrdExp<true>, true>(F.lds, D, S, E);
}
__device__ __forceinline__ void ph_down_fast(Frame& F) {
    const int nt = (int)xb_ld(F.ctl + CW_NTILES);
    pg8::OrdExp<false> S{(const char*)(F.ws + WS_HID), (const char*)(F.ws + WS_WD_T), DE, nullptr, (const int*)(F.ws + WS_TILEE), nt, F.G, F.bid, (size_t)D * DE * 2};
    pg8::EpiBf16 E{(bf16*)(F.ws + WS_Y), D, 1 << 30};
    pg8::gemm_phase<pg8::EpiBf16, pg8::OrdExp<false>, true>(F.lds, DE, S, E);
}
__device__ __forceinline__ void ph_pproj_fast(Frame& F) {
    pg8::OrdStd S; S.init(F.ws + WS_PB, F.ws + WS_WPP_T, T, D, DP, F.G, F.bid);
    pg8::EpiBf16 E{(bf16*)(F.ws + WS_PP), D, 1 << 30};
    pg8::gemm_phase<pg8::EpiBf16, pg8::OrdStd, true>(F.lds, DP, S, E);
}
__device__ __forceinline__ void ph_gate_fast(Frame& F) {
    pg8::OrdStd S; S.init(F.ws + WS_X1B, F.ws + WS_WPG_T, T, D, D, F.G, F.bid);
    pg8::EpiGate E{F.out, (const bf16*)(F.ws + WS_Y), (const bf16*)(F.ws + WS_PP), F.in[I_BPG], (const int*)(F.ws + WS_TOKP), (const float*)(F.ws + WS_TOKW)};
    pg8::gemm_phase<pg8::EpiGate, pg8::OrdStd, true>(F.lds, D, S, E);
}

constexpr int NPHASE = 15;
struct Args { const float* in[35]; float* out; unsigned char* ws; int ph_lo, ph_hi; };
__global__ void __launch_bounds__(NTHR, 2) mk_fwd(Args args) {
    extern __shared__ __attribute__((aligned(16))) unsigned char lds[];
    Frame F;
    F.lds = (LAS unsigned char*)lds; F.sm = (float*)lds;
    F.tid = threadIdx.x; F.lane = F.tid & 63; F.wave = __builtin_amdgcn_readfirstlane(F.tid >> 6); F.G = gridDim.x; F.bid = blockIdx.x;
    F.ws = args.ws; F.out = args.out; F.ctl = (unsigned*)(args.ws + WS_CTL);
#pragma unroll
    for (int i = 0; i < 35; ++i) F.in[i] = args.in[i];
    volatile LAS unsigned* MISC = (volatile LAS unsigned*)(F.lds + MISC_OFF);
    for (int u = F.tid; u < (LDS_BYTES - LDSCTL_OFF) / 4; u += NTHR) ((LAS unsigned*)(F.lds + LDSCTL_OFF))[u] = 0u;
    __syncthreads();
    XcdBarrier bar; bar.bar = F.ctl + CW_BAR; bar.x = 0; bar.st = nullptr;
    if (!MK_PER_PHASE) bar = xcd_barrier_post(F.ctl + CW_BAR, MISC + 8);
    const int lo = args.ph_lo, hi = args.ph_hi;
#define IN(k) (lo <= (k) && (k) < hi)
#define SEAM(k) do { if (IN(k) && IN((k) + 1)) xcd_barrier(bar); } while (0)
    if (IN(0)) { ph_wconv_small(F); ph_ln0(F); }
    SEAM(0);
    if (IN(1)) { if (FAST_PROJ) ph_proj_fast(F); else ph_proj(F); }
    SEAM(1);
    if (IN(2)) { ph_prep(F); ph_zstat(F); }
    SEAM(2);
    if (IN(3)) ph_gmlp(F);
    SEAM(3);
    if (IN(4)) ph_wkv_naive(F);
    SEAM(4);
    if (IN(5)) { if (FAST_WOUT) ph_wout_fast(F); else ph_wout(F); }
    SEAM(5);
    if (IN(6)) ph_rowln(F, F.in[I_LN1G], F.in[I_LN1B], (bf16*)(F.ws + WS_X1B));
    SEAM(6);
    if (IN(7)) { ph_route(F); ph_wconv_exp(F); }
    SEAM(7);
    if (IN(8)) ph_bucket(F);
    SEAM(8);
    if (IN(9)) { if (FAST_UP) ph_up_fast(F); else ph_up(F); }
    SEAM(9);
    if (IN(10)) { if (FAST_DOWN) ph_down_fast(F); else ph_down(F); }
    SEAM(10);
    if (IN(11)) { if (FAST_PP) ph_pproj_fast(F); else ph_pproj(F); }
    SEAM(11);
    if (IN(12)) { if (FAST_GATE) ph_gate_fast(F); else ph_gate(F); }
    SEAM(12);
    if (IN(13)) ph_rowln(F, F.in[I_LN2G], F.in[I_LN2B], nullptr);
#undef IN
#undef SEAM
}

extern "C" void kernel_launch(void* const* d_in, const int* in_sizes, int n_in, void* d_out, int out_size, void* d_ws, size_t ws_size, hipStream_t stream) {
    static int grid = 0;
    if (grid == 0) {
        if (n_in != 35 || out_size != T * D || ws_size < WS_END) { fprintf(stderr, "kernel_launch: unexpected shapes n_in %d out %d ws %zu (need %zu)\n", n_in, out_size, ws_size, (size_t)WS_END); grid = -1; return; }
        int dev = 0, cus = 0, per_cu = 0;
        if (hipGetDevice(&dev) != hipSuccess || hipDeviceGetAttribute(&cus, hipDeviceAttributeMultiprocessorCount, dev) != hipSuccess) { grid = -1; return; }
        if (hipFuncSetAttribute((const void*)mk_fwd, hipFuncAttributeMaxDynamicSharedMemorySize, LDS_BYTES) != hipSuccess) { fprintf(stderr, "kernel_launch: hipFuncSetAttribute failed\n"); grid = -1; return; }
        if (hipOccupancyMaxActiveBlocksPerMultiprocessor(&per_cu, (const void*)mk_fwd, NTHR, LDS_BYTES) != hipSuccess || per_cu < 1) fprintf(stderr, "kernel_launch: occupancy query says %d\n", per_cu);
        (void)hipGetLastError();
        grid = cus;
    }
    if (grid < 0) return;
    if (hipMemsetAsync((char*)d_ws + WS_CTL, 0, CTL_ZERO_BYTES, stream) != hipSuccess) return;
    Args a{};
    for (int i = 0; i < 35; ++i) a.in[i] = (const float*)d_in[i];
    a.out = (float*)d_out; a.ws = (unsigned char*)d_ws;
#if MK_PER_PHASE
    for (int ph = 0; ph < NPHASE - 1; ++ph) { a.ph_lo = ph; a.ph_hi = ph + 1; hipLaunchKernelGGL(mk_fwd, dim3(grid), dim3(NTHR), LDS_BYTES, stream, a); }
#else
    a.ph_lo = 0; a.ph_hi = NPHASE; hipLaunchKernelGGL(mk_fwd, dim3(grid), dim3(NTHR), LDS_BYTES, stream, a);
#endif
}
```

```cpp
#include <hip/hip_runtime.h>
#include <cstdio>
#include <cstdint>

#ifndef FAST_WKV
#define FAST_WKV 1
#endif
#ifndef FAST_PROJ
#define FAST_PROJ 1
#endif
#ifndef FAST_WOUT
#define FAST_WOUT 1
#endif
#ifndef FAST_UP
#define FAST_UP 1
#endif
#ifndef FAST_DOWN
#define FAST_DOWN 1
#endif
#ifndef FAST_PP
#define FAST_PP 1
#endif
#ifndef FAST_GATE
#define FAST_GATE 1
#endif
#ifndef MK_PER_PHASE
#define MK_PER_PHASE 0
#endif

constexpr int BATCH = 4, SEQ = 4096, T = BATCH * SEQ, D = 1024, DIN = 2816, NSH = 1792, DR = 512, NH = 8, HD = 64;
constexpr int DG = 512, GG = 4, GW = 128, CH = 128, NE = 32, DE = 512, DP = 256;
constexpr int NSLOT = 40960;
constexpr int NTILE256 = NSLOT / 256;
constexpr float ALPHA = 1.189207115f, LN_EPS = 1e-5f, GN_EPS = 64e-5f, DECAY_SCALE = 0.6065306597f;

constexpr size_t MiB = 1u << 20;
constexpr size_t WS_CTL = 0, CTL_ZERO_BYTES = 1 * MiB;
constexpr size_t WS_STAT0 = 1 * MiB;
constexpr size_t WS_ZSTAT = WS_STAT0 + 128 * 1024;
constexpr size_t WS_TOKE = WS_ZSTAT + 512 * 1024;
constexpr size_t WS_TOKW = WS_TOKE + 128 * 1024;
constexpr size_t WS_TOKP = WS_TOKW + 128 * 1024;
constexpr size_t WS_SLOTTOK = WS_TOKP + 128 * 1024;
constexpr size_t WS_TILEE = WS_SLOTTOK + 256 * 1024;
constexpr size_t WS_WIN_T = 4 * MiB;
constexpr size_t WS_WOUT_T = 10 * MiB, WS_WPG_T = 12 * MiB, WS_WPP_T = 14 * MiB;
constexpr size_t WS_XN = 15 * MiB;
constexpr size_t WS_PROJ = 47 * MiB;
constexpr size_t WS_R = 135 * MiB, WS_K = 151 * MiB, WS_V = 167 * MiB, WS_KK = 183 * MiB, WS_KB = 199 * MiB, WS_LW = 215 * MiB, WS_G = 231 * MiB;
constexpr size_t WS_CAT = 247 * MiB;
constexpr size_t WS_CM = 47 * MiB, WS_CN = 63 * MiB, WS_CP = 79 * MiB, WS_CY = 95 * MiB, WS_CH = 111 * MiB, WS_CC = 127 * MiB;
constexpr size_t WS_X1B = WS_XN;
constexpr size_t WS_WGU_T = 47 * MiB;
constexpr size_t WS_WD_T = 111 * MiB;
constexpr size_t WS_HID = 143 * MiB;
constexpr size_t WS_Y = 183 * MiB;
constexpr size_t WS_PB = 263 * MiB;
constexpr size_t WS_PP = 143 * MiB;
constexpr size_t WS_END = 284 * MiB;
constexpr int CW_TMO = 0, CW_CODE = 1;
constexpr int CW_ECNT = 1024;
constexpr int CW_NTILES = 1100;
constexpr int CW_BAR = 4096;

constexpr int NWAVES = 8, NTHR = 512;
constexpr int RING_BYTES = 131072, LDSCTL_OFF = RING_BYTES, MISC_OFF = LDSCTL_OFF + 320, LDS_BYTES = 147456;

#define GAS __attribute__((address_space(1)))
#define LAS __attribute__((address_space(3)))
typedef unsigned short bf16;
typedef GAS unsigned gu32;
#define RLX_AGENT __ATOMIC_RELAXED, __HIP_MEMORY_SCOPE_AGENT

__device__ __forceinline__ float bf2f(bf16 v) { return __uint_as_float(((unsigned)v) << 16); }
__device__ __forceinline__ bf16 f2bf(float f) { unsigned u = __float_as_uint(f); return (bf16)((u + 0x7fffu + ((u >> 16) & 1u)) >> 16); }
__device__ __forceinline__ float wave_sum(float v) {
#pragma unroll
    for (int o = 1; o < 64; o <<= 1) v += __shfl_xor(v, o);
    return v;
}
__device__ __forceinline__ float sigmoidf_(float x) { return 1.0f / (1.0f + __expf(-x)); }

#define XB_TMO      128
#define XB_XCNT(j)  (256  + 64 * (j))
#define XB_XSUB(j)  (1280 + 64 * (j))
#define XB_XGEN(j)  (2304 + 64 * (j))
#define XB_TOP      3328
#define XB_TOPGEN   3392
#define XCD_BAR_WORDS 3456
#define XB_SPIN_CAP (1u << 18)
__device__ __forceinline__ unsigned xb_ld(unsigned* p)              { return __hip_atomic_load(p, __ATOMIC_RELAXED, __HIP_MEMORY_SCOPE_AGENT); }
__device__ __forceinline__ unsigned xb_add(unsigned* p, unsigned v) { return __hip_atomic_fetch_add(p, v, __ATOMIC_RELAXED, __HIP_MEMORY_SCOPE_AGENT); }
__device__ __forceinline__ unsigned xb_xcc_id() { return (unsigned)__builtin_amdgcn_s_getreg((3 << 11) | 20) & 0xFu; }
#define XB_SPIN(cond, bar) do { unsigned _sp = 0; while (cond) { __builtin_amdgcn_s_sleep(1); \
    if ((++_sp & 255u) == 0u) { if (xb_ld(&(bar)[XB_TMO])) break; if (_sp > XB_SPIN_CAP) { atomicAdd(&(bar)[XB_TMO], 1u); break; } } } } while (0)
struct XcdBarrier { unsigned* bar; unsigned x; volatile LAS unsigned* st; };
__device__ __forceinline__ XcdBarrier xcd_barrier_post(unsigned* bar, volatile LAS unsigned* st) {
    XcdBarrier b; b.bar = bar; b.x = xb_xcc_id(); b.st = st;
    if (threadIdx.x == 0) (void)xb_add(&bar[XB_XCNT(b.x)], 1u);
    return b;
}
__device__ __forceinline__ void xcd_barrier_complete(unsigned* bar, unsigned x, unsigned& nloc, unsigned& nx) {
    const unsigned G = gridDim.x * gridDim.y * gridDim.z;
    unsigned sum, cnt, mine, sp = 0u;
    for (;;) {
        sum = 0u; cnt = 0u; mine = 0u;
#pragma unroll
        for (unsigned j = 0; j < 16; ++j) { const unsigned c = xb_ld(&bar[XB_XCNT(j)]); sum += c; cnt += (c > 0u) ? 1u : 0u; mine = (j == x) ? c : mine; }
        if (sum == G) break;
        __builtin_amdgcn_s_sleep(1);
        if ((++sp & 255u) == 0u) { if (xb_ld(&bar[XB_TMO])) break; if (sp > XB_SPIN_CAP) { atomicAdd(&bar[XB_TMO], 1u); break; } }
    }
    nloc = mine > 0u ? mine : 1u; nx = cnt > 0u ? cnt : 1u;
}
__device__ __forceinline__ void xcd_barrier(const XcdBarrier& b) {
    asm volatile("s_waitcnt vmcnt(0)" ::: "memory");
    __syncthreads();
    if (threadIdx.x == 0) {
        unsigned* bar = b.bar;
        __builtin_amdgcn_s_waitcnt(0);
        unsigned nloc = b.st[0], nx = b.st[1];
        if (nloc == 0u) { xcd_barrier_complete(bar, b.x, nloc, nx); b.st[0] = nloc; b.st[1] = nx; }
        const unsigned old = xb_add(&bar[XB_XSUB(b.x)], 1u);
        const unsigned gen = old / nloc;
        if (old + 1u == (gen + 1u) * nloc) {
            __builtin_amdgcn_fence(__ATOMIC_RELEASE, "agent");
            asm volatile("s_waitcnt vmcnt(0)" ::: "memory");
            const unsigned og = xb_add(&bar[XB_TOP], 1u);
            const unsigned tg = og / nx;
            if (og + 1u == (tg + 1u) * nx) xb_add(&bar[XB_TOPGEN], 1u);
            else XB_SPIN(xb_ld(&bar[XB_TOPGEN]) == tg, bar);
            __builtin_amdgcn_fence(__ATOMIC_ACQUIRE, "agent");
            xb_add(&bar[XB_XGEN(b.x)], 1u);
            asm volatile("s_waitcnt vmcnt(0)" ::: "memory");
        } else {
            XB_SPIN(xb_ld(&bar[XB_XGEN(b.x)]) == gen, bar);
            __builtin_amdgcn_fence(__ATOMIC_ACQUIRE, "agent");
            asm volatile("s_waitcnt vmcnt(0)" ::: "memory");
        }
    }
    __syncthreads();
}

struct Frame {
    LAS unsigned char* lds;
    float* sm;
    unsigned* ctl;
    int tid, lane, wave, G, bid;
    const float* in[35];
    float* out;
    unsigned char* ws;
};
enum { I_X = 0, I_P, I_LNEG, I_LNEB, I_WIN, I_MU, I_W0, I_WDEC, I_A0, I_WICLR, I_WGATE, I_KK, I_KA, I_RK, I_GNG, I_GNB, I_GLNG, I_GLNB, I_WSP, I_BSP,
       I_WOUT, I_LN1G, I_LN1B, I_WGR, I_BGR, I_WER, I_BER, I_WEG, I_WEU, I_WED, I_WPG, I_BPG, I_WPP, I_LN2G, I_LN2B };

template <class AF, class BF, class EF>
__device__ __forceinline__ void sgemm_tile(float* sA, float* sB, int tid, int m0, int n0, int K, AF af, BF bf, EF ef) {
    const int tx = tid & 15, ty = tid >> 4;
    float acc[4][4];
#pragma unroll
    for (int i = 0; i < 4; ++i)
#pragma unroll
        for (int j = 0; j < 4; ++j) acc[i][j] = 0.f;
    for (int k0 = 0; k0 < K; k0 += 16) {
        float ra[4], rb[2];
#pragma unroll
        for (int i = 0; i < 4; ++i) { const int idx = tid + i * 512, m = idx >> 4, k = idx & 15; ra[i] = af(m0 + m, k0 + k); }
#pragma unroll
        for (int i = 0; i < 2; ++i) { const int idx = tid + i * 512, k = idx >> 6, n = idx & 63; rb[i] = bf(k0 + k, n0 + n); }
        __syncthreads();
#pragma unroll
        for (int i = 0; i < 4; ++i) { const int idx = tid + i * 512, m = idx >> 4, k = idx & 15; sA[k * 132 + m] = ra[i]; }
#pragma unroll
        for (int i = 0; i < 2; ++i) { const int idx = tid + i * 512, k = idx >> 6, n = idx & 63; sB[k * 68 + n] = rb[i]; }
        __syncthreads();
#pragma unroll
        for (int k = 0; k < 16; ++k) {
            const float4 a = *(const float4*)(sA + k * 132 + ty * 4), b = *(const float4*)(sB + k * 68 + tx * 4);
            const float av[4] = {a.x, a.y, a.z, a.w}, bv[4] = {b.x, b.y, b.z, b.w};
#pragma unroll
            for (int i = 0; i < 4; ++i)
#pragma unroll
                for (int j = 0; j < 4; ++j) acc[i][j] = fmaf(av[i], bv[j], acc[i][j]);
        }
    }
    ef(m0 + ty * 4, n0 + tx * 4, acc);
    __syncthreads();
}

__device__ __forceinline__ void ph_ln0(Frame& F) {
    const float* x = F.in[I_X]; const float* g = F.in[I_LNEG]; const float* b = F.in[I_LNEB];
    bf16* XN = (bf16*)(F.ws + WS_XN); float* st = (float*)(F.ws + WS_STAT0);
    const int gw = F.bid * NWAVES + F.wave, NGW = F.G * NWAVES;
    for (int m = gw; m < T; m += NGW) {
        const float* xr = x + (size_t)m * D; float v[16]; float s = 0.f;
#pragma unroll
        for (int j = 0; j < 16; ++j) { v[j] = xr[F.lane + 64 * j]; s += v[j]; }
        const float mean = wave_sum(s) * (1.f / D); float q = 0.f;
#pragma unroll
        for (int j = 0; j < 16; ++j) { const float d = v[j] - mean; q += d * d; }
        const float rstd = 1.0f / sqrtf(wave_sum(q) * (1.f / D) + LN_EPS);
#pragma unroll
        for (int j = 0; j < 16; ++j) { const int c = F.lane + 64 * j; XN[(size_t)m * D + c] = f2bf((v[j] - mean) * rstd * g[c] + b[c]); }
        if (F.lane == 0) { st[2 * m] = mean; st[2 * m + 1] = rstd; }
    }
}
__device__ __forceinline__ void ph_proj(Frame& F) {
    const bf16* XN = (const bf16*)(F.ws + WS_XN); const float* W = F.in[I_WIN]; bf16* PR = (bf16*)(F.ws + WS_PROJ);
    float* sA = F.sm; float* sB = F.sm + 16 * 132;
    const int ntn = DIN / 64, ntm = T / 128;
    for (int tile = F.bid; tile < ntm * ntn; tile += F.G) {
        const int m0 = (tile / ntn) * 128, n0 = (tile % ntn) * 64;
        sgemm_tile(sA, sB, F.tid, m0, n0, D,
            [&](int m, int k) { return bf2f(XN[(size_t)m * D + k]); },
            [&](int k, int n) { return W[(size_t)k * DIN + n]; },
            [&](int mb, int nb, float (&acc)[4][4]) {
#pragma unroll
                for (int i = 0; i < 4; ++i)
#pragma unroll
                    for (int j = 0; j < 4; ++j) { float v = acc[i][j]; const int n = nb + j; if (n >= NSH) v = 0.5f * v * (1.0f + erff(v * 0.70710678f)); PR[(size_t)(mb + i) * DIN + n] = f2bf(v); }
            });
    }
}
__device__ __forceinline__ void ph_prep(Frame& F) {
    const bf16* PR = (const bf16*)(F.ws + WS_PROJ);
    const float* mu = F.in[I_MU]; const float* w0 = F.in[I_W0]; const float* Wd = F.in[I_WDEC]; const float* a0 = F.in[I_A0]; const float* Wa = F.in[I_WICLR]; const float* Wg = F.in[I_WGATE];
    const float* k_k = F.in[I_KK]; const float* k_a = F.in[I_KA];
    bf16* oR = (bf16*)(F.ws + WS_R); bf16* oK = (bf16*)(F.ws + WS_K); bf16* oV = (bf16*)(F.ws + WS_V); bf16* oKK = (bf16*)(F.ws + WS_KK); bf16* oKB = (bf16*)(F.ws + WS_KB);
    bf16* oLW = (bf16*)(F.ws + WS_LW); bf16* oG = (bf16*)(F.ws + WS_G);
    float* h = F.sm;
    const int c = F.tid;
    for (int t = F.bid; t < T; t += F.G) {
        __syncthreads();
        for (int cc = c; cc < NSH; cc += NTHR) {
            const float cur = bf2f(PR[(size_t)t * DIN + cc]);
            const float prev = (t % SEQ == 0) ? 0.f : bf2f(PR[(size_t)(t - 1) * DIN + cc]);
            float v = cur + (prev - cur) * mu[cc];
            if (cc >= 1536 && cc < 1600) v = tanhf(v);
            if (cc >= 1664) v = sigmoidf_(v);
            h[cc] = v;
        }
        __syncthreads();
        float d = w0[c], ai = a0[c], g = 0.f;
#pragma unroll 4
        for (int j = 0; j < 64; ++j) { d = fmaf(h[1536 + j], Wd[j * DR + c], d); ai = fmaf(h[1600 + j], Wa[j * DR + c], ai); }
#pragma unroll 4
        for (int j = 0; j < 128; ++j) g = fmaf(h[1664 + j], Wg[j * DR + c], g);
        const float lw = -DECAY_SCALE * sigmoidf_(d), ic = sigmoidf_(ai);
        const float k = h[512 + c]; float kk = k * k_k[c];
        const float nrm = sqrtf(wave_sum(kk * kk)); kk = kk / fmaxf(nrm, 1e-12f);
        const float kmod = k * (1.0f + (ic - 1.0f) * k_a[c]);
        const size_t o = (size_t)t * DR + c;
        oR[o] = f2bf(h[c]); oK[o] = f2bf(kmod); oV[o] = f2bf(h[1024 + c]); oKK[o] = f2bf(kk); oKB[o] = f2bf(kk * ic); oLW[o] = f2bf(lw); oG[o] = f2bf(g);
    }
    __syncthreads();
}
__device__ __forceinline__ void ph_zstat(Frame& F) {
    const bf16* PR = (const bf16*)(F.ws + WS_PROJ); float* zs = (float*)(F.ws + WS_ZSTAT);
    const int gw = F.bid * NWAVES + F.wave, NGW = F.G * NWAVES;
    for (int it = gw; it < T * GG; it += NGW) {
        const int t = it >> 2, g = it & 3; const bf16* p = PR + (size_t)t * DIN + NSH + DG + g * GW;
        const float a = bf2f(p[F.lane]), b = bf2f(p[F.lane + 64]);
        const float mean = wave_sum(a + b) * (1.f / GW); const float da = a - mean, db = b - mean;
        const float rstd = 1.0f / sqrtf(wave_sum(da * da + db * db) * (1.f / GW) + LN_EPS);
        if (F.lane == 0) { zs[2 * it] = mean; zs[2 * it + 1] = rstd; }
    }
}
__device__ __forceinline__ void ph_gmlp(Frame& F) {
    const bf16* PR = (const bf16*)(F.ws + WS_PROJ); const float* zs = (const float*)(F.ws + WS_ZSTAT);
    const float* lg = F.in[I_GLNG]; const float* lb = F.in[I_GLNB]; const float* wsp = F.in[I_WSP]; const float* bsp = F.in[I_BSP];
    bf16* CAT = (bf16*)(F.ws + WS_CAT);
    const int c = F.tid, g = c >> 7; const float gg = lg[c], gb = lb[c];
    for (int t = F.bid; t < T; t += F.G) {
        const int tl = t & (CH - 1), t0 = t - tl; const float* wrow = wsp + ((size_t)g * CH + tl) * CH;
        float acc = bsp[g * CH + tl];
        for (int sl = 0; sl <= tl; ++sl) {
            const int s = t0 + sl; const float zv = bf2f(PR[(size_t)s * DIN + NSH + DG + c]);
            const float zn = (zv - zs[(s * 4 + g) * 2]) * zs[(s * 4 + g) * 2 + 1] * gg + gb;
            acc = fmaf(wrow[sl], zn, acc);
        }
        const float zu = bf2f(PR[(size_t)t * DIN + NSH + c]);
        CAT[(size_t)t * D + DR + c] = f2bf(zu * acc);
    }
}
__device__ __forceinline__ void ph_wkv_naive(Frame& F) {
    const bf16* iR = (const bf16*)(F.ws + WS_R); const bf16* iK = (const bf16*)(F.ws + WS_K); const bf16* iV = (const bf16*)(F.ws + WS_V); const bf16* iKK = (const bf16*)(F.ws + WS_KK); const bf16* iKB = (const bf16*)(F.ws + WS_KB);
    const bf16* iLW = (const bf16*)(F.ws + WS_LW); const bf16* iG = (const bf16*)(F.ws + WS_G);
    const float* r_k = F.in[I_RK]; const float* gng = F.in[I_GNG]; const float* gnb = F.in[I_GNB];
    bf16* CAT = (bf16*)(F.ws + WS_CAT);
    if (F.wave != 0) return;
    float* sv = F.sm;
    for (int seq = F.bid; seq < BATCH * NH; seq += F.G) {
        const int b = seq / NH, hh = seq % NH; const int ch = hh * HD + F.lane;
        float st[64];
#pragma unroll
        for (int j = 0; j < 64; ++j) st[j] = 0.f;
        const float rk = r_k[ch], gg = gng[ch], gb = gnb[ch];
        for (int tb = 0; tb < SEQ; tb += 16) {
            for (int s = 0; s < 16; ++s) {
                const size_t o = (size_t)(b * SEQ + tb + s) * DR + ch;
                sv[(s * 5 + 0) * 64 + F.lane] = -bf2f(iKK[o]);
                sv[(s * 5 + 1) * 64 + F.lane] = __expf(bf2f(iLW[o]));
                sv[(s * 5 + 2) * 64 + F.lane] = bf2f(iKB[o]);
                sv[(s * 5 + 3) * 64 + F.lane] = bf2f(iK[o]);
                sv[(s * 5 + 4) * 64 + F.lane] = bf2f(iR[o]);
            }
            __builtin_amdgcn_s_waitcnt(0); __builtin_amdgcn_wave_barrier();
            for (int s = 0; s < 16; ++s) {
                const size_t o = (size_t)(b * SEQ + tb + s) * DR + ch;
                const float v = bf2f(iV[o]);
                const float* pa = sv + (s * 5 + 0) * 64; const float* pw = pa + 64; const float* pb = pa + 128; const float* pk = pa + 192; const float* pr = pa + 256;
                float sa = 0.f;
#pragma unroll
                for (int j = 0; j < 64; ++j) sa = fmaf(st[j], pa[j], sa);
                float y = 0.f;
#pragma unroll
                for (int j = 0; j < 64; ++j) { st[j] = fmaf(st[j], pw[j], fmaf(sa, pb[j], v * pk[j])); y = fmaf(st[j], pr[j], y); }
                const float m = wave_sum(y) * (1.f / 64.f); const float dy = y - m; const float var = wave_sum(dy * dy) * (1.f / 64.f);
                const float yn = dy * (1.0f / sqrtf(var + GN_EPS)) * gg + gb;
                const float bonus = wave_sum(pr[F.lane] * pk[F.lane] * rk) * v;
                CAT[(size_t)(b * SEQ + tb + s) * D + ch] = f2bf((yn + bonus) * bf2f(iG[o]));
            }
            __builtin_amdgcn_s_waitcnt(0); __builtin_amdgcn_wave_barrier();
        }
    }
}
__device__ __forceinline__ void ph_wout(Frame& F) {
    const bf16* CAT = (const bf16*)(F.ws + WS_CAT); const float* W = F.in[I_WOUT]; const float* x = F.in[I_X]; const float* st = (const float*)(F.ws + WS_STAT0);
    const float* g = F.in[I_LNEG]; const float* b = F.in[I_LNEB]; float* out = F.out;
    float* sA = F.sm; float* sB = F.sm + 16 * 132;
    const int ntn = D / 64, ntm = T / 128;
    for (int tile = F.bid; tile < ntm * ntn; tile += F.G) {
        const int m0 = (tile / ntn) * 128, n0 = (tile % ntn) * 64;
        sgemm_tile(sA, sB, F.tid, m0, n0, D,
            [&](int m, int k) { return bf2f(CAT[(size_t)m * D + k]); },
            [&](int k, int n) { return W[(size_t)k * D + n]; },
            [&](int mb, int nb, float (&acc)[4][4]) {
#pragma unroll
                for (int i = 0; i < 4; ++i) { const int m = mb + i; const float mean = st[2 * m], rstd = st[2 * m + 1];
#pragma unroll
                    for (int j = 0; j < 4; ++j) { const int n = nb + j; const float xn = (x[(size_t)m * D + n] - mean) * rstd * g[n] + b[n]; out[(size_t)m * D + n] = ALPHA * xn + acc[i][j]; } }
            });
    }
}
__device__ __forceinline__ void ph_rowln(Frame& F, const float* g, const float* b, bf16* xb) {
    float* out = F.out;
    const int gw = F.bid * NWAVES + F.wave, NGW = F.G * NWAVES;
    for (int m = gw; m < T; m += NGW) {
        float* xr = out + (size_t)m * D; float v[16]; float s = 0.f;
#pragma unroll
        for (int j = 0; j < 16; ++j) { v[j] = xr[F.lane + 64 * j]; s += v[j]; }
        const float mean = wave_sum(s) * (1.f / D); float q = 0.f;
#pragma unroll
        for (int j = 0; j < 16; ++j) { const float d = v[j] - mean; q += d * d; }
        const float rstd = 1.0f / sqrtf(wave_sum(q) * (1.f / D) + LN_EPS);
#pragma unroll
        for (int j = 0; j < 16; ++j) { const int c = F.lane + 64 * j; const float o = (v[j] - mean) * rstd * g[c] + b[c]; xr[c] = o; if (xb) xb[(size_t)m * D + c] = f2bf(o); }
    }
}
__device__ __forceinline__ void ph_route(Frame& F) {
    const float* x1 = F.out; const float* Wgr = F.in[I_WGR]; const float* bgr = F.in[I_BGR]; const float* Wer = F.in[I_WER]; const float* ber = F.in[I_BER];
    int* tokE = (int*)(F.ws + WS_TOKE); float* tokW = (float*)(F.ws + WS_TOKW); int* tokP = (int*)(F.ws + WS_TOKP); int* slotTok = (int*)(F.ws + WS_SLOTTOK);
    unsigned* ecnt = F.ctl + CW_ECNT;
    for (int i = F.bid * NTHR + F.tid; i < NSLOT; i += F.G * NTHR) slotTok[i] = -1;
    const int gw = F.bid * NWAVES + F.wave, NGW = F.G * NWAVES;
    for (int t = gw; t < T; t += NGW) {
        const float* xr = x1 + (size_t)t * D; float acc = 0.f; const int o = F.lane;
        if (o < 4) { for (int k = 0; k < D; ++k) acc = fmaf(xr[k], Wgr[k * 4 + o], acc); acc += bgr[o]; }
        else if (o < 36) { for (int k = 0; k < D; ++k) acc = fmaf(xr[k], Wer[k * 32 + (o - 4)], acc); acc += ber[o - 4]; }
        float gl[4];
#pragma unroll
        for (int j = 0; j < 4; ++j) gl[j] = __shfl(acc, j);
        int gs = 0; float gm = gl[0];
#pragma unroll
        for (int j = 1; j < 4; ++j) if (gl[j] > gm) { gm = gl[j]; gs = j; }
        float se = 0.f;
#pragma unroll
        for (int j = 0; j < 4; ++j) se += __expf(gl[j] - gm);
        const float pg = 1.0f / se;
        float el[8];
#pragma unroll
        for (int j = 0; j < 8; ++j) el[j] = __shfl(acc, 4 + gs * 8 + j);
        int i1 = 0; float v1 = el[0];
#pragma unroll
        for (int j = 1; j < 8; ++j) if (el[j] > v1) { v1 = el[j]; i1 = j; }
        int i2 = -1; float v2 = -3.0e38f;
#pragma unroll
        for (int j = 0; j < 8; ++j) if (j != i1 && el[j] > v2) { v2 = el[j]; i2 = j; }
        const float e2 = __expf(v2 - v1), w1 = pg / (1.0f + e2), w2 = pg * e2 / (1.0f + e2);
        if (F.lane == 0) {
            const int ea = gs * 8 + i1, eb = gs * 8 + i2;
            tokE[2 * t] = ea; tokE[2 * t + 1] = eb; tokW[2 * t] = w1; tokW[2 * t + 1] = w2;
            tokP[2 * t] = (int)atomicAdd(&ecnt[ea], 1u); tokP[2 * t + 1] = (int)atomicAdd(&ecnt[eb], 1u);
        }
    }
}
__device__ __forceinline__ void ph_bucket(Frame& F) {
    int* tokE = (int*)(F.ws + WS_TOKE); int* tokP = (int*)(F.ws + WS_TOKP); int* slotTok = (int*)(F.ws + WS_SLOTTOK); int* tileE = (int*)(F.ws + WS_TILEE);
    unsigned* ecnt = F.ctl + CW_ECNT;
    int* pstart = (int*)F.sm;
    __syncthreads();
    if (F.tid == 0) { int s = 0; for (int e = 0; e < NE; ++e) { pstart[e] = s; s += (((int)xb_ld(&ecnt[e]) + 255) / 256) * 256; } pstart[NE] = s; }
    __syncthreads();
    if (F.bid == 0 && F.tid == 0) __hip_atomic_store(F.ctl + CW_NTILES, (unsigned)(pstart[NE] / 256), RLX_AGENT);
    if (F.bid == 0) for (int tl = F.tid; tl < NTILE256; tl += NTHR) { int e = -1; for (int j = 0; j < NE; ++j) if (tl * 256 >= pstart[j] && tl * 256 < pstart[j + 1]) e = j; tileE[tl] = e; }
    for (int i = F.bid * NTHR + F.tid; i < 2 * T; i += F.G * NTHR) { const int slot = pstart[tokE[i]] + tokP[i]; tokP[i] = slot; slotTok[slot] = i >> 1; }
    __syncthreads();
}
__device__ __forceinline__ void ph_up(Frame& F) {
    const bf16* X1B = (const bf16*)(F.ws + WS_X1B); const float* Weg = F.in[I_WEG]; const float* Weu = F.in[I_WEU]; bf16* HID = (bf16*)(F.ws + WS_HID);
    const int* slotTok = (const int*)(F.ws + WS_SLOTTOK); const int* tileE = (const int*)(F.ws + WS_TILEE);
    float* sA = F.sm; float* sB = F.sm + 16 * 132;
    const int ntn = (2 * DE) / 64, ntm = NSLOT / 128;
    for (int tile = F.bid; tile < ntm * ntn; tile += F.G) {
        const int m0 = (tile / ntn) * 128, n0 = (tile % ntn) * 64; const int e = tileE[m0 >> 8];
        if (e < 0) continue;
        const float* wg = Weg + (size_t)e * D * DE; const float* wu = Weu + (size_t)e * D * DE;
        sgemm_tile(sA, sB, F.tid, m0, n0, D,
            [&](int m, int k) { const int tk = slotTok[m]; return tk >= 0 ? bf2f(X1B[(size_t)tk * D + k]) : 0.f; },
            [&](int k, int n) { return (n & 1) ? wu[(size_t)k * DE + (n >> 1)] : wg[(size_t)k * DE + (n >> 1)]; },
            [&](int mb, int nb, float (&acc)[4][4]) {
#pragma unroll
                for (int i = 0; i < 4; ++i)
#pragma unroll
                    for (int j = 0; j < 2; ++j) { const float gt = acc[i][2 * j], up = acc[i][2 * j + 1]; HID[(size_t)(mb + i) * DE + (nb >> 1) + j] = f2bf(gt * sigmoidf_(gt) * up); }
            });
    }
}
__device__ __forceinline__ void ph_down(Frame& F) {
    const bf16* HID = (const bf16*)(F.ws + WS_HID); const float* Wed = F.in[I_WED]; bf16* Y = (bf16*)(F.ws + WS_Y);
    const int* tileE = (const int*)(F.ws + WS_TILEE);
    float* sA = F.sm; float* sB = F.sm + 16 * 132;
    const int ntn = D / 64, ntm = NSLOT / 128;
    for (int tile = F.bid; tile < ntm * ntn; tile += F.G) {
        const int m0 = (tile / ntn) * 128, n0 = (tile % ntn) * 64; const int e = tileE[m0 >> 8];
        if (e < 0) continue;
        const float* wd = Wed + (size_t)e * DE * D;
        sgemm_tile(sA, sB, F.tid, m0, n0, DE,
            [&](int m, int k) { return bf2f(HID[(size_t)m * DE + k]); },
            [&](int k, int n) { return wd[(size_t)k * D + n]; },
            [&](int mb, int nb, float (&acc)[4][4]) {
#pragma unroll
                for (int i = 0; i < 4; ++i)
#pragma unroll
                    for (int j = 0; j < 4; ++j) Y[(size_t)(mb + i) * D + nb + j] = f2bf(acc[i][j]);
            });
    }
}
__device__ __forceinline__ void ph_pproj(Frame& F) {
    const float* P = F.in[I_P]; const float* W = F.in[I_WPP]; bf16* PP = (bf16*)(F.ws + WS_PP);
    float* sA = F.sm; float* sB = F.sm + 16 * 132;
    const int ntn = D / 64, ntm = T / 128;
    for (int tile = F.bid; tile < ntm * ntn; tile += F.G) {
        const int m0 = (tile / ntn) * 128, n0 = (tile % ntn) * 64;
        sgemm_tile(sA, sB, F.tid, m0, n0, DP,
            [&](int m, int k) { return P[(size_t)m * DP + k]; },
            [&](int k, int n) { return W[(size_t)k * D + n]; },
            [&](int mb, int nb, float (&acc)[4][4]) {
#pragma unroll
                for (int i = 0; i < 4; ++i)
#pragma unroll
                    for (int j = 0; j < 4; ++j) PP[(size_t)(mb + i) * D + nb + j] = f2bf(acc[i][j]);
            });
    }
}
__device__ __forceinline__ void ph_gate(Frame& F) {
    const bf16* X1B = (const bf16*)(F.ws + WS_X1B); const float* W = F.in[I_WPG]; const float* bpg = F.in[I_BPG]; const bf16* PP = (const bf16*)(F.ws + WS_PP); const bf16* Y = (const bf16*)(F.ws + WS_Y);
    const int* tokP = (const int*)(F.ws + WS_TOKP); const float* tokW = (const float*)(F.ws + WS_TOKW); float* out = F.out;
    float* sA = F.sm; float* sB = F.sm + 16 * 132;
    const int ntn = D / 64, ntm = T / 128;
    for (int tile = F.bid; tile < ntm * ntn; tile += F.G) {
        const int m0 = (tile / ntn) * 128, n0 = (tile % ntn) * 64;
        sgemm_tile(sA, sB, F.tid, m0, n0, D,
            [&](int m, int k) { return bf2f(X1B[(size_t)m * D + k]); },
            [&](int k, int n) { return W[(size_t)k * D + n]; },
            [&](int mb, int nb, float (&acc)[4][4]) {
#pragma unroll
                for (int i = 0; i < 4; ++i) { const int m = mb + i; const int s0 = tokP[2 * m], s1 = tokP[2 * m + 1]; const float w0 = tokW[2 * m], w1 = tokW[2 * m + 1];
#pragma unroll
                    for (int j = 0; j < 4; ++j) { const int n = nb + j; const size_t o = (size_t)m * D + n;
                        const float ffn = w0 * bf2f(Y[(size_t)s0 * D + n]) + w1 * bf2f(Y[(size_t)s1 * D + n]);
                        out[o] = ALPHA * out[o] + ffn + sigmoidf_(acc[i][j] + bpg[n]) * bf2f(PP[o]); } }
            });
    }
}


namespace pg8 {
#define PG8_LAS __attribute__((address_space(3)))
typedef unsigned short bf16_t;
typedef short bf16x8 __attribute__((ext_vector_type(8)));
typedef float f32x4 __attribute__((ext_vector_type(4)));
typedef float f32x2 __attribute__((ext_vector_type(2)));
typedef unsigned u32x4 __attribute__((ext_vector_type(4)));
typedef unsigned u32x2 __attribute__((ext_vector_type(2)));
constexpr int BM = 256, BK = 64, HALF = 128, HTB = HALF * BK * 2, STAGE_BYTES = 8 * HTB, NXCD = 8, WGM = 8;
__host__ __device__ __forceinline__ int lds_byte(int r, int c) { const int st = (r >> 4) * 2 + (c >> 5), rr = r & 15, cc = c & 31, ob = rr * 64 + cc * 2; return st * 1024 + (ob ^ (((ob >> 9) & 1) << 5)); }
__host__ __device__ __forceinline__ void stage_rc(int b, int& R, int& C) { const int st = b / 1024, sb = b % 1024, swz = sb ^ (((sb >> 9) & 1) << 5); R = (st >> 1) * 16 + swz / 64; C = (st & 1) * 32 + (swz % 64) / 2; }
__host__ __device__ __forceinline__ int perm32(int rho) { const int n = rho >> 4, i = rho & 15; return 8 * (i >> 2) + 4 * n + (i & 3); }
struct Unit { int pm, pn; };

struct OrdStd {
    const char* A; const char* Bt; int K; int nM, nN, nwg, G, c;
    __device__ __forceinline__ void init(const void* A_, const void* Bt_, int M, int N, int K_, int G_, int c_) { A = (const char*)A_; Bt = (const char*)Bt_; K = K_; nM = M / BM; nN = N / BM; nwg = nM * nN; G = G_; c = c_; }
    __device__ __forceinline__ bool next(int i, Unit& u) const {
        const long L = (long)i * G + c; if (L >= nwg) return false;
        int wgid = (int)L; { const int q = nwg / NXCD, r = nwg % NXCD, xcd = wgid % NXCD, off = wgid / NXCD; wgid = (xcd < r ? xcd * (q + 1) : r * (q + 1) + (xcd - r) * q) + off; }
        const int nig = WGM * nN, gid = wgid / nig, fm = gid * WGM, gsz = (nM - fm) < WGM ? (nM - fm) : WGM;
        u.pm = fm + ((wgid % nig) % gsz); u.pn = (wgid % nig) / gsz; return true;
    }
    __device__ __forceinline__ const char* a_ptr(const Unit& u) const { return A + (size_t)u.pm * BM * K * 2; }
    __device__ __forceinline__ const char* b_ptr(const Unit& u) const { return Bt + (size_t)u.pn * BM * K * 2; }
    __device__ __forceinline__ void a_off(const Unit&, const int (&R)[2], const int (&C)[2], unsigned (&v)[2][2]) const {
#pragma unroll
        for (int h = 0; h < 2; ++h)
#pragma unroll
            for (int i = 0; i < 2; ++i) v[h][i] = (unsigned)((R[i] + HALF * h) * K + C[i]) * 2u;
    }
};
template <bool GATHER> struct OrdExp {
    const char* A; const char* Bt; int K; const int* slotTok; const int* tileE; int ntiles, G, c; size_t estride;
    __device__ __forceinline__ bool next(int i, Unit& u) const { const int L = i * G + c; if (L >= ntiles * 4) return false; u.pm = L >> 2; u.pn = L & 3; return true; }
    __device__ __forceinline__ const char* a_ptr(const Unit& u) const { return GATHER ? A : A + (size_t)u.pm * BM * K * 2; }
    __device__ __forceinline__ const char* b_ptr(const Unit& u) const { const int e = tileE[u.pm]; return Bt + (size_t)e * estride + (size_t)u.pn * BM * K * 2; }
    __device__ __forceinline__ void a_off(const Unit& u, const int (&R)[2], const int (&C)[2], unsigned (&v)[2][2]) const {
#pragma unroll
        for (int h = 0; h < 2; ++h)
#pragma unroll
            for (int i = 0; i < 2; ++i) {
                int row = R[i] + HALF * h;
                if (GATHER) { row = slotTok[u.pm * BM + row]; row = row < 0 ? 0 : row; }
                v[h][i] = (unsigned)(row * K + C[i]) * 2u;
            }
    }
};

__device__ __forceinline__ unsigned cvt_pk_bf16(float lo, float hi) { unsigned r; asm volatile("v_cvt_pk_bf16_f32 %0, %1, %2" : "=v"(r) : "v"(lo), "v"(hi)); return r; }
__device__ __forceinline__ f32x2 gelu_pk(f32x2 v) {
    const f32x2 av = __builtin_elementwise_abs(v), d = av * 0.2316418882f + 1.0f;
    f32x2 t; t.x = __builtin_amdgcn_rcpf(d.x); t.y = __builtin_amdgcn_rcpf(d.y);
    f32x2 q = t * 0.5307027145f + (-0.7265760135f); q = q * t + 0.7107068705f; q = q * t + (-0.142248368f); q = q * t + 0.127414796f; q = q * t;
    const f32x2 s = (v * v) * (-0.72134752044f);
    f32x2 e; e.x = __builtin_amdgcn_exp2f(s.x); e.y = __builtin_amdgcn_exp2f(s.y);
    const f32x2 m = v * (q * e), r = v - m;
    f32x2 o; o.x = v.x < 0.f ? m.x : r.x; o.y = v.y < 0.f ? m.y : r.y; return o;
}
__device__ __forceinline__ float bfl(unsigned w) { return __uint_as_float(w << 16); }
__device__ __forceinline__ float bfh(unsigned w) { return __uint_as_float(w & 0xffff0000u); }
__device__ __forceinline__ float sigm(float x) { return __builtin_amdgcn_rcpf(1.0f + __expf(-x)); }

struct EpiBf16 {
    static constexpr bool PERM = true;
    bf16_t* O; int ldc; int gelu_from_pn;
    __device__ __forceinline__ void operator()(const f32x4 (&acc)[2][2][4][2], const Unit& u, int wr, int wc, int fr, int fq) const {
        const int row0 = u.pm * BM + wr * 64 + fr, col0 = u.pn * BM + wc * 32 + 8 * fq; const bool act = u.pn >= gelu_from_pn;
#pragma unroll
        for (int ai = 0; ai < 2; ++ai)
#pragma unroll
            for (int m = 0; m < 4; ++m) { bf16_t* rowp = O + (size_t)(row0 + ai * HALF + m * 16) * ldc + col0;
#pragma unroll
                for (int bj = 0; bj < 2; ++bj) { f32x4 v0 = acc[ai][bj][m][0], v1 = acc[ai][bj][m][1];
                    if (act) { f32x2 a = gelu_pk((f32x2){v0[0], v0[1]}), b = gelu_pk((f32x2){v0[2], v0[3]}), c = gelu_pk((f32x2){v1[0], v1[1]}), d = gelu_pk((f32x2){v1[2], v1[3]});
                        v0 = (f32x4){a.x, a.y, b.x, b.y}; v1 = (f32x4){c.x, c.y, d.x, d.y}; }
                    u32x4 w; w.x = cvt_pk_bf16(v0[0], v0[1]); w.y = cvt_pk_bf16(v0[2], v0[3]); w.z = cvt_pk_bf16(v1[0], v1[1]); w.w = cvt_pk_bf16(v1[2], v1[3]);
                    *(u32x4*)(rowp + bj * HALF) = w; } }
    }
};
struct EpiUp {
    static constexpr bool PERM = true;
    bf16_t* HIDp;
    __device__ __forceinline__ void operator()(const f32x4 (&acc)[2][2][4][2], const Unit& u, int wr, int wc, int fr, int fq) const {
        const int row0 = u.pm * BM + wr * 64 + fr, hcol0 = u.pn * 128 + wc * 16 + 4 * fq;
#pragma unroll
        for (int ai = 0; ai < 2; ++ai)
#pragma unroll
            for (int m = 0; m < 4; ++m) { bf16_t* rowp = HIDp + (size_t)(row0 + ai * HALF + m * 16) * DE + hcol0;
#pragma unroll
                for (int bj = 0; bj < 2; ++bj) { const f32x4 v0 = acc[ai][bj][m][0], v1 = acc[ai][bj][m][1];
                    const float h0 = v0[0] * sigm(v0[0]) * v0[1], h1 = v0[2] * sigm(v0[2]) * v0[3], h2 = v1[0] * sigm(v1[0]) * v1[1], h3 = v1[2] * sigm(v1[2]) * v1[3];
                    u32x2 w; w.x = cvt_pk_bf16(h0, h1); w.y = cvt_pk_bf16(h2, h3);
                    *(u32x2*)(rowp + bj * 64) = w; } }
    }
};
struct EpiWout {
    static constexpr bool PERM = false;
    const float* x; const float* st; const float* g; const float* b; float* out;
    __device__ __forceinline__ void operator()(const f32x4 (&acc)[2][2][4][2], const Unit& u, int wr, int wc, int fr, int fq) const {
        const int col0 = u.pn * BM + wc * 32 + 4 * fq;
        f32x4 gv[2][2], bv[2][2];
#pragma unroll
        for (int bj = 0; bj < 2; ++bj)
#pragma unroll
            for (int n = 0; n < 2; ++n) { gv[bj][n] = *(const f32x4*)(g + col0 + bj * HALF + n * 16); bv[bj][n] = *(const f32x4*)(b + col0 + bj * HALF + n * 16); }
#pragma unroll
        for (int ai = 0; ai < 2; ++ai)
#pragma unroll
            for (int m = 0; m < 4; ++m) { const int row = u.pm * BM + ai * HALF + wr * 64 + m * 16 + fr; const float mean = st[2 * row], rstd = st[2 * row + 1]; const size_t off = (size_t)row * D + col0;
#pragma unroll
                for (int bj = 0; bj < 2; ++bj)
#pragma unroll
                    for (int n = 0; n < 2; ++n) { const f32x4 xv = *(const f32x4*)(x + off + bj * HALF + n * 16);
                        *(f32x4*)(out + off + bj * HALF + n * 16) = ((xv - mean) * rstd * gv[bj][n] + bv[bj][n]) * ALPHA + acc[ai][bj][m][n]; }
                asm volatile("" ::: "memory"); }
    }
};
struct EpiGate {
    static constexpr bool PERM = false;
    float* out; const bf16_t* Y; const bf16_t* PP; const float* bias; const int* tokP; const float* tokW;
    __device__ __forceinline__ void operator()(const f32x4 (&acc)[2][2][4][2], const Unit& u, int wr, int wc, int fr, int fq) const {
        const int col0 = u.pn * BM + wc * 32 + 4 * fq;
        f32x4 bv[2][2];
#pragma unroll
        for (int bj = 0; bj < 2; ++bj)
#pragma unroll
            for (int n = 0; n < 2; ++n) bv[bj][n] = *(const f32x4*)(bias + col0 + bj * HALF + n * 16);
#pragma unroll
        for (int ai = 0; ai < 2; ++ai)
#pragma unroll
            for (int m = 0; m < 4; ++m) { const int row = u.pm * BM + ai * HALF + wr * 64 + m * 16 + fr; const size_t off = (size_t)row * D + col0;
                const int s0 = tokP[2 * row], s1 = tokP[2 * row + 1]; const float w0 = tokW[2 * row], w1 = tokW[2 * row + 1];
                const bf16_t* y0p = Y + (size_t)s0 * D + col0; const bf16_t* y1p = Y + (size_t)s1 * D + col0;
#pragma unroll
                for (int bj = 0; bj < 2; ++bj)
#pragma unroll
                    for (int n = 0; n < 2; ++n) { const int co = bj * HALF + n * 16;
                        const f32x4 xv = *(const f32x4*)(out + off + co); const u32x2 ya = *(const u32x2*)(y0p + co), yb = *(const u32x2*)(y1p + co), pp = *(const u32x2*)(PP + off + co);
                        const f32x4 a = acc[ai][bj][m][n] + bv[bj][n];
                        f32x4 o;
                        o[0] = ALPHA * xv[0] + w0 * bfl(ya.x) + w1 * bfl(yb.x) + sigm(a[0]) * bfl(pp.x);
                        o[1] = ALPHA * xv[1] + w0 * bfh(ya.x) + w1 * bfh(yb.x) + sigm(a[1]) * bfh(pp.x);
                        o[2] = ALPHA * xv[2] + w0 * bfl(ya.y) + w1 * bfl(yb.y) + sigm(a[2]) * bfl(pp.y);
                        o[3] = ALPHA * xv[3] + w0 * bfh(ya.y) + w1 * bfh(yb.y) + sigm(a[3]) * bfh(pp.y);
                        *(f32x4*)(out + off + co) = o; }
                asm volatile("" ::: "memory"); }
    }
};

template <class Epi, class Sched, bool ALIGN_EPI>
__device__ __forceinline__ void gemm_phase(PG8_LAS unsigned char* lds, const int K, const Sched& S, const Epi& E) {
    const int tid = threadIdx.x, wid = __builtin_amdgcn_readfirstlane(tid >> 6), lane = tid & 63, wr = wid >> 2, wc = wid & 3, fr = lane & 15, fq = lane >> 4;
    const int nt = K / BK;
    unsigned voffB[2]; int Rr[2], Cc[2];
#pragma unroll
    for (int i = 0; i < 2; ++i) { int R, C; stage_rc(tid * 16 + i * 8192, R, C); const int Rb = Epi::PERM ? ((R & ~31) + perm32(R & 31)) : R; Rr[i] = R; Cc[i] = C; voffB[i] = (unsigned)(Rb * K + C) * 2u; }
    const size_t kstep = (size_t)(BK * 2);
    const size_t hstep = (size_t)HALF * K * 2;
    const unsigned ldsw = (unsigned)wid * 1024u;
    const int aoff = lds_byte(wr * 64 + fr, fq * 8), boff = lds_byte(wc * 32 + fr, fq * 8);
#define PG8_SA(b, h) (((b) * 2 + (h)) * HTB)
#define PG8_SB(b, h) ((4 + (b) * 2 + (h)) * HTB)
#define PG8_STAGE(bufoff, gbase, voff) do { _Pragma("unroll") for (int _i = 0; _i < 2; ++_i) \
        __builtin_amdgcn_global_load_lds((const unsigned*)((const char*)(gbase) + (voff)[_i]), (PG8_LAS unsigned*)(lds + (bufoff) + ldsw + _i * 8192), 16, 0, 0); } while (0)
#define PG8_LDA(dst, b, h) do { _Pragma("unroll") for (int m = 0; m < 4; ++m) _Pragma("unroll") for (int k = 0; k < 2; ++k) dst[m][k] = *(const PG8_LAS bf16x8*)(lds + PG8_SA(b, h) + aoff + m * 2048 + k * 1024); } while (0)
#define PG8_LDB(dst, b, h) do { _Pragma("unroll") for (int n = 0; n < 2; ++n) _Pragma("unroll") for (int k = 0; k < 2; ++k) dst[n][k] = *(const PG8_LAS bf16x8*)(lds + PG8_SB(b, h) + boff + n * 2048 + k * 1024); } while (0)
#define PG8_MMA(ai, bj, At, Bt) do { __builtin_amdgcn_s_setprio(1); _Pragma("unroll") for (int m = 0; m < 4; ++m) _Pragma("unroll") for (int n = 0; n < 2; ++n) _Pragma("unroll") for (int k = 0; k < 2; ++k) \
        acc[ai][bj][m][n] = __builtin_amdgcn_mfma_f32_16x16x32_bf16(Bt[n][k], At[m][k], acc[ai][bj][m][n], 0, 0, 0); __builtin_amdgcn_s_setprio(0); } while (0)
#define PG8_WAIT_V(n) asm volatile("s_waitcnt vmcnt(" #n ")" ::: "memory")
#define PG8_WAIT_L(n) asm volatile("s_waitcnt lgkmcnt(" #n ")" ::: "memory")
#define PG8_BAR __builtin_amdgcn_s_barrier()
#define PG8_SCHED __builtin_amdgcn_sched_barrier(0)
    Unit cur, nxt; int ui = 0;
    if (!S.next(0, cur)) return;
    f32x4 acc[2][2][4][2];
#pragma unroll
    for (int a = 0; a < 2; ++a)
#pragma unroll
        for (int b = 0; b < 2; ++b)
#pragma unroll
            for (int m = 0; m < 4; ++m)
#pragma unroll
                for (int n = 0; n < 2; ++n) acc[a][b][m][n] = (f32x4){0.f, 0.f, 0.f, 0.f};
    bf16x8 At[4][2], B0[2][2], B1[2][2];
    unsigned vAc[2][2], vAn[2][2];
    S.a_off(cur, Rr, Cc, vAc);
    const char* cA = S.a_ptr(cur); const char* cB = S.b_ptr(cur);
    PG8_STAGE(PG8_SB(0, 0), cB, voffB); PG8_STAGE(PG8_SB(0, 1), cB + hstep, voffB); PG8_STAGE(PG8_SA(0, 0), cA, vAc[0]); PG8_STAGE(PG8_SA(0, 1), cA, vAc[1]);
    if (wr == 1) PG8_BAR;
    PG8_WAIT_V(2); PG8_BAR;
    PG8_STAGE(PG8_SB(1, 0), cB + kstep, voffB); PG8_STAGE(PG8_SA(1, 0), cA + kstep, vAc[0]); PG8_STAGE(PG8_SB(1, 1), cB + hstep + kstep, voffB);
    PG8_WAIT_V(6); PG8_BAR;
    for (;;) {
        const bool has_next = S.next(ui + 1, nxt);
        const char* nA = cA; const char* nB = cB;
#pragma unroll
        for (int h = 0; h < 2; ++h)
#pragma unroll
            for (int i = 0; i < 2; ++i) vAn[h][i] = vAc[h][i];
        if (has_next) { nA = S.a_ptr(nxt); nB = S.b_ptr(nxt); S.a_off(nxt, Rr, Cc, vAn); }
        for (int t = 0; t < nt; t += 2) {
            const bool last = (t == nt - 2);
            const char* a1 = cA + (size_t)(t + 1) * kstep;
            const char* a2 = last ? nA : cA + (size_t)(t + 2) * kstep; const char* b2 = last ? nB : cB + (size_t)(t + 2) * kstep;
            const char* a3 = a2 + kstep; const char* b3 = b2 + kstep;
            unsigned s0[2], s1[2];
#pragma unroll
            for (int i = 0; i < 2; ++i) { s0[i] = last ? vAn[0][i] : vAc[0][i]; s1[i] = last ? vAn[1][i] : vAc[1][i]; }
            PG8_LDB(B0, 0, 0); PG8_LDB(B1, 0, 1); PG8_SCHED; PG8_LDA(At, 0, 0); PG8_STAGE(PG8_SA(1, 1), a1, vAc[1]);
            PG8_WAIT_V(8); PG8_WAIT_L(0); PG8_BAR; PG8_MMA(0, 0, At, B0); PG8_MMA(0, 1, At, B1); PG8_BAR; PG8_SCHED;
            PG8_LDA(At, 0, 1); PG8_STAGE(PG8_SB(0, 0), b2, voffB); PG8_STAGE(PG8_SB(0, 1), b2 + hstep, voffB); PG8_STAGE(PG8_SA(0, 0), a2, s0);
            PG8_WAIT_V(8); PG8_WAIT_L(0); PG8_BAR; PG8_MMA(1, 0, At, B0); PG8_MMA(1, 1, At, B1); PG8_BAR; PG8_SCHED;
            PG8_LDB(B0, 1, 0); PG8_LDB(B1, 1, 1); PG8_SCHED; PG8_LDA(At, 1, 0); PG8_STAGE(PG8_SA(0, 1), a2, s1);
            PG8_WAIT_V(8); PG8_WAIT_L(0); PG8_BAR; PG8_MMA(0, 0, At, B0); PG8_MMA(0, 1, At, B1); PG8_BAR; PG8_SCHED;
            PG8_LDA(At, 1, 1); PG8_STAGE(PG8_SB(1, 0), b3, voffB); PG8_STAGE(PG8_SB(1, 1), b3 + hstep, voffB); PG8_STAGE(PG8_SA(1, 0), a3, s0);
            PG8_WAIT_V(8); PG8_WAIT_L(0); PG8_BAR; PG8_MMA(1, 0, At, B0); PG8_MMA(1, 1, At, B1); PG8_BAR; PG8_SCHED;
        }
        if constexpr (ALIGN_EPI) { if (wr == 0) PG8_BAR; }
        E(acc, cur, wr, wc, fr, fq);
        if (!has_next) break;
#pragma unroll
        for (int a = 0; a < 2; ++a)
#pragma unroll
            for (int b = 0; b < 2; ++b)
#pragma unroll
                for (int m = 0; m < 4; ++m)
#pragma unroll
                    for (int n = 0; n < 2; ++n) acc[a][b][m][n] = (f32x4){0.f, 0.f, 0.f, 0.f};
        cur = nxt; cA = nA; cB = nB; ++ui;
#pragma unroll
        for (int h = 0; h < 2; ++h)
#pragma unroll
            for (int i = 0; i < 2; ++i) vAc[h][i] = vAn[h][i];
        if constexpr (ALIGN_EPI) { if (wr == 1) PG8_BAR; }
    }
    PG8_WAIT_V(0);
    if constexpr (!ALIGN_EPI) { if (wr == 0) PG8_BAR; }
    PG8_BAR;
#undef PG8_SA
#undef PG8_SB
#undef PG8_STAGE
#undef PG8_LDA
#undef PG8_LDB
#undef PG8_MMA
#undef PG8_WAIT_V
#undef PG8_WAIT_L
#undef PG8_BAR
#undef PG8_SCHED
}
}

__device__ __forceinline__ unsigned pk2(float lo, float hi) { return (unsigned)f2bf(lo) | ((unsigned)f2bf(hi) << 16); }
typedef unsigned v4u __attribute__((ext_vector_type(4)));
__device__ __forceinline__ void transpose_item(const float* W, int K, int N, bf16* WT, int row_off, int row_mul, LAS float* scr, int item, int lane) {
    const int nblk = N / 32, kb = item / nblk, nb = item % nblk, k0 = 64 * kb, n0 = 32 * nb;
#pragma unroll 8
    for (int i = 0; i < 32; ++i) { const int kk = 2 * i + (lane >> 5); scr[kk * 33 + (lane & 31)] = W[(size_t)(k0 + kk) * N + n0 + (lane & 31)]; }
    asm volatile("s_waitcnt lgkmcnt(0)" ::: "memory");
    const int c = lane & 7;
#pragma unroll
    for (int j = 0; j < 4; ++j) { const int n = (lane >> 3) + 8 * j; const LAS float* s = scr + (8 * c) * 33 + n;
        v4u o; o.x = pk2(s[0 * 33], s[1 * 33]); o.y = pk2(s[2 * 33], s[3 * 33]); o.z = pk2(s[4 * 33], s[5 * 33]); o.w = pk2(s[6 * 33], s[7 * 33]);
        *(GAS v4u*)(WT + (size_t)(row_off + row_mul * (n0 + n)) * K + k0 + 8 * c) = o; }
    asm volatile("s_waitcnt lgkmcnt(0)" ::: "memory");
}
__device__ __forceinline__ void ph_wconv_small(Frame& F) {
    LAS float* scr = (LAS float*)(F.lds + F.wave * 16384);
    const int gw = F.bid * NWAVES + F.wave, NGW = F.G * NWAVES;
    constexpr int I_IN = (D / 64) * (DIN / 32), I_O = (D / 64) * (D / 32), I_PP = (DP / 64) * (D / 32);
    constexpr int NIT = I_IN + 2 * I_O + I_PP;
    for (int it = gw; it < NIT; it += NGW) {
        int r = it;
        if (r < I_IN) { transpose_item(F.in[I_WIN], D, DIN, (bf16*)(F.ws + WS_WIN_T), 0, 1, scr, r, F.lane); continue; } r -= I_IN;
        if (r < I_O) { transpose_item(F.in[I_WOUT], D, D, (bf16*)(F.ws + WS_WOUT_T), 0, 1, scr, r, F.lane); continue; } r -= I_O;
        if (r < I_O) { transpose_item(F.in[I_WPG], D, D, (bf16*)(F.ws + WS_WPG_T), 0, 1, scr, r, F.lane); continue; } r -= I_O;
        transpose_item(F.in[I_WPP], DP, D, (bf16*)(F.ws + WS_WPP_T), 0, 1, scr, r, F.lane);
    }
}
__device__ __forceinline__ void ph_wconv_exp(Frame& F) {
    LAS float* scr = (LAS float*)(F.lds + F.wave * 16384);
    const int gw = F.bid * NWAVES + F.wave, NGW = F.G * NWAVES;
    constexpr int I_G = (D / 64) * (DE / 32), I_D = (DE / 64) * (D / 32), PER_E = 2 * I_G + I_D;
    for (int it = gw; it < NE * PER_E; it += NGW) {
        const int e = it / PER_E; int r = it % PER_E;
        bf16* gu = (bf16*)(F.ws + WS_WGU_T) + (size_t)e * (2 * DE) * D; bf16* dn = (bf16*)(F.ws + WS_WD_T) + (size_t)e * D * DE;
        if (r < I_G) { transpose_item(F.in[I_WEG] + (size_t)e * D * DE, D, DE, gu, 0, 2, scr, r, F.lane); continue; } r -= I_G;
        if (r < I_G) { transpose_item(F.in[I_WEU] + (size_t)e * D * DE, D, DE, gu, 1, 2, scr, r, F.lane); continue; } r -= I_G;
        transpose_item(F.in[I_WED] + (size_t)e * DE * D, DE, D, dn, 0, 1, scr, r, F.lane);
    }
    const float4* p4 = (const float4*)F.in[I_P]; uint2* pb = (uint2*)(F.ws + WS_PB);
    for (size_t i = (size_t)F.bid * NTHR + F.tid; i < (size_t)T * DP / 4; i += (size_t)F.G * NTHR) { const float4 v = p4[i]; uint2 o; o.x = pk2(v.x, v.y); o.y = pk2(v.z, v.w); pb[i] = o; }
}
__device__ __forceinline__ void ph_proj_fast(Frame& F) {
    pg8::OrdStd S; S.init(F.ws + WS_XN, F.ws + WS_WIN_T, T, DIN, D, F.G, F.bid);
    pg8::EpiBf16 E{(bf16*)(F.ws + WS_PROJ), DIN, NSH / 256};
    pg8::gemm_phase<pg8::EpiBf16, pg8::OrdStd, true>(F.lds, D, S, E);
}
__device__ __forceinline__ void ph_wout_fast(Frame& F) {
    pg8::OrdStd S; S.init(F.ws + WS_CAT, F.ws + WS_WOUT_T, T, D, D, F.G, F.bid);
    pg8::EpiWout E{F.in[I_X], (const float*)(F.ws + WS_STAT0), F.in[I_LNEG], F.in[I_LNEB], F.out};
    pg8::gemm_phase<pg8::EpiWout, pg8::OrdStd, true>(F.lds, D, S, E);
}
__device__ __forceinline__ void ph_up_fast(Frame& F) {
    const int nt = (int)xb_ld(F.ctl + CW_NTILES);
    pg8::OrdExp<true> S{(const char*)(F.ws + WS_X1B), (const char*)(F.ws + WS_WGU_T), D, (const int*)(F.ws + WS_SLOTTOK), (const int*)(F.ws + WS_TILEE), nt, F.G, F.bid, (size_t)(2 * DE) * D * 2};
    pg8::EpiUp E{(bf16*)(F.ws + WS_HID)};
    pg8::gemm_phase<pg8::EpiUp, pg8::OrdExp<true>, true>(F.lds, D, S, E);
}
__device__ __forceinline__ void ph_down_fast(Frame& F) {
    const int nt = (int)xb_ld(F.ctl + CW_NTILES);
    pg8::OrdExp<false> S{(const char*)(F.ws + WS_HID), (const char*)(F.ws + WS_WD_T), DE, nullptr, (const int*)(F.ws + WS_TILEE), nt, F.G, F.bid, (size_t)D * DE * 2};
    pg8::EpiBf16 E{(bf16*)(F.ws + WS_Y), D, 1 << 30};
    pg8::gemm_phase<pg8::EpiBf16, pg8::OrdExp<false>, true>(F.lds, DE, S, E);
}
__device__ __forceinline__ void ph_pproj_fast(Frame& F) {
    pg8::OrdStd S; S.init(F.ws + WS_PB, F.ws + WS_WPP_T, T, D, DP, F.G, F.bid);
    pg8::EpiBf16 E{(bf16*)(F.ws + WS_PP), D, 1 << 30};
    pg8::gemm_phase<pg8::EpiBf16, pg8::OrdStd, true>(F.lds, DP, S, E);
}
__device__ __forceinline__ void ph_gate_fast(Frame& F) {
    pg8::OrdStd S; S.init(F.ws + WS_X1B, F.ws + WS_WPG_T, T, D, D, F.G, F.bid);
    pg8::EpiGate E{F.out, (const bf16*)(F.ws + WS_Y), (const bf16*)(F.ws + WS_PP), F.in[I_BPG], (const int*)(F.ws + WS_TOKP), (const float*)(F.ws + WS_TOKW)};
    pg8::gemm_phase<pg8::EpiGate, pg8::OrdStd, true>(F.lds, D, S, E);
}


namespace wk {
typedef short bf16x8 __attribute__((ext_vector_type(8)));
typedef float f32x4 __attribute__((ext_vector_type(4)));
typedef unsigned u32x2 __attribute__((ext_vector_type(2)));
typedef unsigned u32x4 __attribute__((ext_vector_type(4)));
constexpr int WST = 72;
constexpr int WBUF = 64 * WST * 2;
constexpr int NCHUNK = BATCH * NH * (SEQ / 64);
__device__ __forceinline__ LAS bf16* buf(LAS unsigned char* lds, int i) { return (LAS bf16*)(lds + i * WBUF); }
typedef __bf16 bf16v2 __attribute__((ext_vector_type(2)));
__device__ __forceinline__ unsigned pk(float lo, float hi) { bf16v2 v = {(__bf16)lo, (__bf16)hi}; return __builtin_bit_cast(unsigned, v); }
__device__ __forceinline__ f32x4 tile_mm(f32x4 acc, const LAS bf16* First, int f0, const LAS bf16* Second, int s0, int c, int q) {
    const LAS bf16* ap = First + (f0 + c) * WST + 8 * q; const LAS bf16* bp = Second + (s0 + c) * WST + 8 * q;
    const bf16x8 a0 = *(const LAS bf16x8*)ap, a1 = *(const LAS bf16x8*)(ap + 32), b0 = *(const LAS bf16x8*)bp, b1 = *(const LAS bf16x8*)(bp + 32);
    acc = __builtin_amdgcn_mfma_f32_16x16x32_bf16(a0, b0, acc, 0, 0, 0);
    acc = __builtin_amdgcn_mfma_f32_16x16x32_bf16(a1, b1, acc, 0, 0, 0);
    return acc;
}
__device__ __forceinline__ void write_rm(LAS bf16* dst, int m0, int n0, f32x4 acc, int c, int q) {
#pragma unroll
    for (int r = 0; r < 4; ++r) dst[(m0 + 4 * q + r) * WST + n0 + c] = f2bf(acc[r]);
}
__device__ __forceinline__ void write_tr(LAS bf16* dst, int m0, int n0, f32x4 acc, int c, int q) {
    u32x2 w; w.x = pk(acc[0], acc[1]); w.y = pk(acc[2], acc[3]);
    *(LAS u32x2*)(dst + (n0 + c) * WST + m0 + 4 * q) = w;
}
__device__ __forceinline__ f32x4 read_tr(const LAS bf16* XT, int m0, int n0, int c, int q) {
    const u32x2 w = *(const LAS u32x2*)(XT + (n0 + c) * WST + m0 + 4 * q);
    return (f32x4){pg8::bfl(w.x), pg8::bfh(w.x), pg8::bfl(w.y), pg8::bfh(w.y)};
}
__device__ __forceinline__ f32x4 read_rm4(const LAS bf16* X, int m0, int n0, int c, int q) {
    const u32x2 w = *(const LAS u32x2*)(X + (m0 + c) * WST + n0 + 4 * q);
    return (f32x4){pg8::bfl(w.x), pg8::bfh(w.x), pg8::bfl(w.y), pg8::bfh(w.y)};
}
__device__ __forceinline__ void store4(bf16* g, f32x4 v) { u32x2 w; w.x = pk(v[0], v[1]); w.y = pk(v[2], v[3]); *(u32x2*)g = w; }
}

__device__ __forceinline__ void ph_wkv1(Frame& F) {
    using namespace wk;
    const bf16* iR = (const bf16*)(F.ws + WS_R); const bf16* iK = (const bf16*)(F.ws + WS_K); const bf16* iV = (const bf16*)(F.ws + WS_V); const bf16* iKK = (const bf16*)(F.ws + WS_KK); const bf16* iKB = (const bf16*)(F.ws + WS_KB);
    const bf16* iLW = (const bf16*)(F.ws + WS_LW); const float* r_k = F.in[I_RK];
    bf16* oM = (bf16*)(F.ws + WS_CM); bf16* oN = (bf16*)(F.ws + WS_CN); bf16* oP = (bf16*)(F.ws + WS_CP); bf16* oY = (bf16*)(F.ws + WS_CY); float* oC = (float*)(F.ws + WS_CC);
    LAS unsigned char* L = F.lds; LAS float* scr = (LAS float*)(L + 14 * WBUF);
    const int lane = F.lane, w = F.wave, c = lane & 15, q = lane >> 4;
    for (int cid = F.bid; cid < NCHUNK; cid += F.G) {
        const int seq = cid >> 6, cc = cid & 63, b = seq >> 3, h = seq & 7; const int t0 = b * SEQ + cc * 64;
        const int j = lane, tq = w;
        const size_t g0 = (size_t)(t0 + 8 * tq) * DR + h * 64 + j;
        float lw[8], cs[8]; float s = 0.f;
#pragma unroll
        for (int e = 0; e < 8; ++e) { lw[e] = bf2f(iLW[g0 + (size_t)e * DR]); s += lw[e]; cs[e] = s; }
        scr[tq * 64 + j] = s;
        __syncthreads();
        float pre = 0.f, tot = 0.f;
#pragma unroll
        for (int qq = 0; qq < 8; ++qq) { const float x = scr[qq * 64 + j]; tot += x; pre += (qq < tq) ? x : 0.f; }
        const float rkj = r_k[h * 64 + j];
        unsigned vT[4], aT[4], bhT[4], khT[4]; float prv = 0.f, pra = 0.f, prb = 0.f, prk = 0.f;
#pragma unroll
        for (int e = 0; e < 8; ++e) {
            const int t = 8 * tq + e; const float cse = cs[e] + pre;
            const float e1 = __expf(cse), ei = __expf(-cse), ep = __expf(cse - lw[e]), eh = __expf(tot - cse);
            const size_t o = g0 + (size_t)e * DR;
            const float rr = bf2f(iR[o]), kv = bf2f(iK[o]), vv = bf2f(iV[o]), kkv = bf2f(iKK[o]), kbv = bf2f(iKB[o]);
            const float at = -kkv * ep, rt = rr * e1, bt = kbv * ei, kt = kv * ei, bh = kbv * eh, kh = kv * eh;
            buf(L, 0)[t * WST + j] = f2bf(at); buf(L, 1)[t * WST + j] = f2bf(rt); buf(L, 2)[t * WST + j] = f2bf(bt); buf(L, 3)[t * WST + j] = f2bf(kt);
            if (e & 1) { vT[e >> 1] = pk(prv, vv); aT[e >> 1] = pk(pra, at); bhT[e >> 1] = pk(prb, bh); khT[e >> 1] = pk(prk, kh); }
            else { prv = vv; pra = at; prb = bh; prk = kh; }
            const float bon = wave_sum(rr * kv * rkj);
            if (lane == 0) oC[(size_t)(t0 + t) * NH + h] = bon;
        }
        *(LAS u32x4*)(buf(L, 4) + j * WST + 8 * tq) = (u32x4){vT[0], vT[1], vT[2], vT[3]};
        *(LAS u32x4*)(buf(L, 5) + j * WST + 8 * tq) = (u32x4){aT[0], aT[1], aT[2], aT[3]};
        *(LAS u32x4*)(buf(L, 6) + j * WST + 8 * tq) = (u32x4){bhT[0], bhT[1], bhT[2], bhT[3]};
        *(LAS u32x4*)(buf(L, 7) + j * WST + 8 * tq) = (u32x4){khT[0], khT[1], khT[2], khT[3]};
        __syncthreads();
        if (w == 0) scr[j] = __expf(tot);
#pragma unroll 1
        for (int it = 0; it < 8; ++it) {
            const int tile = w * 8 + it, prod = tile >> 4, tm = (tile >> 2) & 3, tn = tile & 3;
            const LAS bf16* A = buf(L, (prod >> 1) ? 1 : 0); const LAS bf16* B = buf(L, (prod & 1) ? 3 : 2);
            f32x4 acc = (f32x4){0.f, 0.f, 0.f, 0.f};
            if (tn <= tm) acc = tile_mm(acc, A, 16 * tm, B, 16 * tn, c, q);
#pragma unroll
            for (int r = 0; r < 4; ++r) { const int m = 16 * tm + 4 * q + r, n = 16 * tn + c; const bool keep = (prod < 2) ? (n < m) : (n <= m); acc[r] = keep ? acc[r] : 0.f; }
            write_rm(buf(L, prod == 0 ? 8 : 9 + prod), 16 * tm, 16 * tn, acc, c, q);
            if (prod == 0) { write_tr(buf(L, 9), 16 * tm, 16 * tn, acc, c, q); f32x4 t1 = acc;
#pragma unroll
                for (int r = 0; r < 4; ++r) t1[r] += (16 * tm + 4 * q + r == 16 * tn + c) ? 1.0f : 0.f;
                write_tr(buf(L, 13), 16 * tm, 16 * tn, t1, c, q); }
        }
        __syncthreads();
#define WK_SQ(sq_rm, sq_tr, d_rm, d_tr, tile) do { const int tm = ((tile) >> 2) & 3, tn = (tile) & 3; f32x4 acc = (f32x4){0.f, 0.f, 0.f, 0.f}; \
            acc = tile_mm(acc, buf(L, sq_rm), 16 * tm, buf(L, sq_tr), 16 * tn, c, q); write_rm(buf(L, d_rm), 16 * tm, 16 * tn, acc, c, q); if ((d_tr) >= 0) write_tr(buf(L, (d_tr) < 0 ? 0 : (d_tr)), 16 * tm, 16 * tn, acc, c, q); } while (0)
#define WK_TU(p_rm, told_tr, d, final_rm, tile) do { const int tm = ((tile) >> 2) & 3, tn = (tile) & 3; f32x4 acc = read_tr(buf(L, told_tr), 16 * tm, 16 * tn, c, q); \
            acc = tile_mm(acc, buf(L, p_rm), 16 * tm, buf(L, told_tr), 16 * tn, c, q); if (final_rm) write_rm(buf(L, d), 16 * tm, 16 * tn, acc, c, q); else write_tr(buf(L, d), 16 * tm, 16 * tn, acc, c, q); } while (0)
#pragma unroll 1
        for (int it = 0; it < 4; ++it) { const int tile = w * 4 + it;
            if (tile < 16) WK_SQ(8, 9, 0, 2, tile);
            else { const int tm = (tile >> 2) & 3, tn = tile & 3; f32x4 acc = (f32x4){0.f, 0.f, 0.f, 0.f}; acc = tile_mm(acc, buf(L, 10), 16 * tm, buf(L, 4), 16 * tn, c, q); write_tr(buf(L, 3), 16 * tm, 16 * tn, acc, c, q); } }
        __syncthreads();
#pragma unroll 1
        for (int it = 0; it < 4; ++it) { const int tile = w * 4 + it; if (tile < 16) WK_SQ(0, 2, 8, 9, tile); else WK_TU(0, 13, 10, false, tile); }
        __syncthreads();
#pragma unroll 1
        for (int it = 0; it < 4; ++it) { const int tile = w * 4 + it; if (tile < 16) WK_SQ(8, 9, 0, 2, tile); else WK_TU(8, 10, 13, false, tile); }
        __syncthreads();
#pragma unroll 1
        for (int it = 0; it < 4; ++it) { const int tile = w * 4 + it; if (tile < 16) WK_SQ(0, 2, 8, 9, tile); else WK_TU(0, 13, 10, false, tile); }
        __syncthreads();
#pragma unroll 1
        for (int it = 0; it < 4; ++it) { const int tile = w * 4 + it; if (tile < 16) WK_SQ(8, 9, 0, -1, tile); else WK_TU(8, 10, 13, false, tile); }
        __syncthreads();
#pragma unroll 1
        for (int it = 0; it < 2; ++it) { const int tile = w * 2 + it; WK_TU(0, 13, 2, true, tile); }
        __syncthreads();
#pragma unroll 1
        for (int it = 0; it < 4; ++it) { const int tile = w * 4 + it, tm = (tile >> 2) & 3, tn = tile & 3; f32x4 acc = (f32x4){0.f, 0.f, 0.f, 0.f};
            acc = tile_mm(acc, buf(L, 2), 16 * tm, buf(L, tile < 16 ? 3 : 5), 16 * tn, c, q); write_tr(buf(L, tile < 16 ? 8 : 9), 16 * tm, 16 * tn, acc, c, q); }
        __syncthreads();
        bf16* gP = oP + (size_t)cid * 4096; bf16* gY = oY + (size_t)cid * 4096; bf16* gM = oM + (size_t)cid * 4096; bf16* gN = oN + (size_t)cid * 4096;
#pragma unroll 1
        for (int it = 0; it < 8; ++it) {
            const int tile = w * 8 + it, prod = tile >> 4, tm = (tile >> 2) & 3, tn = tile & 3;
            if (prod == 0) {
                f32x4 acc = read_rm4(buf(L, 1), 16 * tm, 16 * tn, c, q);
                acc = tile_mm(acc, buf(L, 9), 16 * tn, buf(L, 11), 16 * tm, c, q);
                store4(gP + (16 * tm + c) * 64 + 16 * tn + 4 * q, acc);
            } else if (prod == 1) {
                f32x4 acc = (f32x4){0.f, 0.f, 0.f, 0.f};
                acc = tile_mm(acc, buf(L, 8), 16 * tn, buf(L, 11), 16 * tm, c, q);
                acc = tile_mm(acc, buf(L, 4), 16 * tn, buf(L, 12), 16 * tm, c, q);
                store4(gY + (16 * tm + c) * 64 + 16 * tn + 4 * q, acc);
            } else if (prod == 2) {
                f32x4 acc = (f32x4){0.f, 0.f, 0.f, 0.f};
                acc = tile_mm(acc, buf(L, 9), 16 * tn, buf(L, 6), 16 * tm, c, q);
#pragma unroll
                for (int r = 0; r < 4; ++r) acc[r] += (16 * tm + c == 16 * tn + 4 * q + r) ? scr[16 * tm + c] : 0.f;
                store4(gM + (16 * tm + c) * 64 + 16 * tn + 4 * q, acc);
            } else {
                f32x4 acc = (f32x4){0.f, 0.f, 0.f, 0.f};
                acc = tile_mm(acc, buf(L, 6), 16 * tm, buf(L, 8), 16 * tn, c, q);
                acc = tile_mm(acc, buf(L, 7), 16 * tm, buf(L, 4), 16 * tn, c, q);
                store4(gN + (16 * tn + c) * 64 + 16 * tm + 4 * q, acc);
            }
        }
        __syncthreads();
#undef WK_SQ
#undef WK_TU
    }
}
__device__ __forceinline__ void ph_wkv2(Frame& F) {
    using namespace wk;
    if (F.wave != 0) return;
    const bf16* gM = (const bf16*)(F.ws + WS_CM); const bf16* gN = (const bf16*)(F.ws + WS_CN); bf16* gH = (bf16*)(F.ws + WS_CH);
    const int c = F.lane & 15, q = F.lane >> 4;
    for (int task = F.bid; task < 128; task += F.G) {
        const int seq = task >> 2, i0 = (task & 3) * 16;
        f32x4 H[4];
#pragma unroll
        for (int t = 0; t < 4; ++t) H[t] = (f32x4){0.f, 0.f, 0.f, 0.f};
        u32x2 mA[4][2][2], nA[4], mB[4][2][2], nB[4];
#define WK_LOAD(mX, nX, cid) do { const bf16* pm = gM + (size_t)(cid) * 4096; const bf16* pn = gN + (size_t)(cid) * 4096; \
            _Pragma("unroll") for (int to = 0; to < 4; ++to) { nX[to] = *(const u32x2*)(pn + (i0 + c) * 64 + 16 * to + 4 * q); \
            _Pragma("unroll") for (int ks = 0; ks < 2; ++ks) { mX[to][ks][0] = *(const u32x2*)(pm + (16 * to + c) * 64 + 32 * ks + 4 * q); mX[to][ks][1] = *(const u32x2*)(pm + (16 * to + c) * 64 + 32 * ks + 16 + 4 * q); } } } while (0)
#define WK_STEP(mX, nX, cid) do { bf16* ph = gH + (size_t)(cid) * 4096; \
            _Pragma("unroll") for (int to = 0; to < 4; ++to) store4(ph + (i0 + c) * 64 + 16 * to + 4 * q, H[to]); \
            bf16x8 hh[2], hl[2]; \
            _Pragma("unroll") for (int ks = 0; ks < 2; ++ks) { unsigned wh[4], wl[4]; \
                _Pragma("unroll") for (int hf = 0; hf < 2; ++hf) { const f32x4 x = H[2 * ks + hf]; const unsigned p0 = pk(x[0], x[1]), p1 = pk(x[2], x[3]); wh[2 * hf] = p0; wh[2 * hf + 1] = p1; \
                    wl[2 * hf] = pk(x[0] - pg8::bfl(p0), x[1] - pg8::bfh(p0)); wl[2 * hf + 1] = pk(x[2] - pg8::bfl(p1), x[3] - pg8::bfh(p1)); } \
                hh[ks] = __builtin_bit_cast(bf16x8, (u32x4){wh[0], wh[1], wh[2], wh[3]}); hl[ks] = __builtin_bit_cast(bf16x8, (u32x4){wl[0], wl[1], wl[2], wl[3]}); } \
            _Pragma("unroll") for (int to = 0; to < 4; ++to) { f32x4 acc = (f32x4){pg8::bfl(nX[to].x), pg8::bfh(nX[to].x), pg8::bfl(nX[to].y), pg8::bfh(nX[to].y)}; \
                _Pragma("unroll") for (int ks = 0; ks < 2; ++ks) { const bf16x8 mf = __builtin_bit_cast(bf16x8, (u32x4){mX[to][ks][0].x, mX[to][ks][0].y, mX[to][ks][1].x, mX[to][ks][1].y}); \
                    acc = __builtin_amdgcn_mfma_f32_16x16x32_bf16(mf, hh[ks], acc, 0, 0, 0); acc = __builtin_amdgcn_mfma_f32_16x16x32_bf16(mf, hl[ks], acc, 0, 0, 0); } \
                Hn[to] = acc; } \
            _Pragma("unroll") for (int to = 0; to < 4; ++to) H[to] = Hn[to]; } while (0)
        f32x4 Hn[4];
        const int cid0 = seq * 64;
        WK_LOAD(mA, nA, cid0);
#pragma unroll 1
        for (int cc = 0; cc < 64; cc += 2) {
            WK_LOAD(mB, nB, cid0 + cc + 1);
            WK_STEP(mA, nA, cid0 + cc);
            if (cc + 2 < 64) WK_LOAD(mA, nA, cid0 + cc + 2);
            WK_STEP(mB, nB, cid0 + cc + 1);
        }
#undef WK_LOAD
#undef WK_STEP
    }
}
__device__ __forceinline__ void ph_wkv3(Frame& F) {
    using namespace wk;
    const bf16* gP = (const bf16*)(F.ws + WS_CP); const bf16* gY = (const bf16*)(F.ws + WS_CY); const bf16* gH = (const bf16*)(F.ws + WS_CH); const float* gC = (const float*)(F.ws + WS_CC);
    const bf16* iV = (const bf16*)(F.ws + WS_V); const bf16* iG = (const bf16*)(F.ws + WS_G); const float* gng = F.in[I_GNG]; const float* gnb = F.in[I_GNB];
    bf16* CAT = (bf16*)(F.ws + WS_CAT);
    const int c = F.lane & 15, q = F.lane >> 4;
    const int gw = F.bid * NWAVES + F.wave, NGW = F.G * NWAVES;
    for (int cid = gw; cid < NCHUNK; cid += NGW) {
        const int seq = cid >> 6, cc = cid & 63, b = seq >> 3, h = seq & 7; const int t0 = b * SEQ + cc * 64;
        const bf16* pp = gP + (size_t)cid * 4096; const bf16* ph = gH + (size_t)cid * 4096; const bf16* py = gY + (size_t)cid * 4096;
        bf16x8 hf[4][2];
#pragma unroll
        for (int ti = 0; ti < 4; ++ti)
#pragma unroll
            for (int ks = 0; ks < 2; ++ks) hf[ti][ks] = *(const bf16x8*)(ph + (16 * ti + c) * 64 + 32 * ks + 8 * q);
        f32x4 gg[4], gb[4];
#pragma unroll
        for (int ti = 0; ti < 4; ++ti) { gg[ti] = *(const f32x4*)(gng + h * 64 + 16 * ti + 4 * q); gb[ti] = *(const f32x4*)(gnb + h * 64 + 16 * ti + 4 * q); }
#pragma unroll 1
        for (int tt = 0; tt < 4; ++tt) {
            const bf16x8 p0 = *(const bf16x8*)(pp + (16 * tt + c) * 64 + 8 * q), p1 = *(const bf16x8*)(pp + (16 * tt + c) * 64 + 32 + 8 * q);
            f32x4 y[4]; float s = 0.f;
#pragma unroll
            for (int ti = 0; ti < 4; ++ti) { const u32x2 y0 = *(const u32x2*)(py + (16 * tt + c) * 64 + 16 * ti + 4 * q);
                f32x4 acc = (f32x4){pg8::bfl(y0.x), pg8::bfh(y0.x), pg8::bfl(y0.y), pg8::bfh(y0.y)};
                acc = __builtin_amdgcn_mfma_f32_16x16x32_bf16(hf[ti][0], p0, acc, 0, 0, 0); acc = __builtin_amdgcn_mfma_f32_16x16x32_bf16(hf[ti][1], p1, acc, 0, 0, 0);
                y[ti] = acc; s += (acc[0] + acc[1]) + (acc[2] + acc[3]); }
            s += __shfl_xor(s, 16); s += __shfl_xor(s, 32);
            const float mean = s * (1.f / 64.f); float v2 = 0.f;
#pragma unroll
            for (int ti = 0; ti < 4; ++ti) { y[ti] = y[ti] - mean; v2 += (y[ti][0] * y[ti][0] + y[ti][1] * y[ti][1]) + (y[ti][2] * y[ti][2] + y[ti][3] * y[ti][3]); }
            v2 += __shfl_xor(v2, 16); v2 += __shfl_xor(v2, 32);
            const float rstd = 1.0f / sqrtf(v2 * (1.f / 64.f) + GN_EPS);
            const int tg = t0 + 16 * tt + c; const float bon = gC[(size_t)tg * NH + h];
#pragma unroll
            for (int ti = 0; ti < 4; ++ti) { const size_t o = (size_t)tg * DR + h * 64 + 16 * ti + 4 * q;
                const u32x2 vv = *(const u32x2*)(iV + o), gv = *(const u32x2*)(iG + o);
                f32x4 r;
                r[0] = (y[ti][0] * rstd * gg[ti][0] + gb[ti][0] + bon * pg8::bfl(vv.x)) * pg8::bfl(gv.x);
                r[1] = (y[ti][1] * rstd * gg[ti][1] + gb[ti][1] + bon * pg8::bfh(vv.x)) * pg8::bfh(gv.x);
                r[2] = (y[ti][2] * rstd * gg[ti][2] + gb[ti][2] + bon * pg8::bfl(vv.y)) * pg8::bfl(gv.y);
                r[3] = (y[ti][3] * rstd * gg[ti][3] + gb[ti][3] + bon * pg8::bfh(vv.y)) * pg8::bfh(gv.y);
                store4(CAT + (size_t)tg * D + h * 64 + 16 * ti + 4 * q, r); }
        }
    }
}

constexpr int NPHASE = 17;
struct Args { const float* in[35]; float* out; unsigned char* ws; int ph_lo, ph_hi; };
__global__ void __launch_bounds__(NTHR, 2) mk_fwd(Args args) {
    extern __shared__ __attribute__((aligned(16))) unsigned char lds[];
    Frame F;
    F.lds = (LAS unsigned char*)lds; F.sm = (float*)lds;
    F.tid = threadIdx.x; F.lane = F.tid & 63; F.wave = __builtin_amdgcn_readfirstlane(F.tid >> 6); F.G = gridDim.x; F.bid = blockIdx.x;
    F.ws = args.ws; F.out = args.out; F.ctl = (unsigned*)(args.ws + WS_CTL);
#pragma unroll
    for (int i = 0; i < 35; ++i) F.in[i] = args.in[i];
    volatile LAS unsigned* MISC = (volatile LAS unsigned*)(F.lds + MISC_OFF);
    for (int u = F.tid; u < (LDS_BYTES - LDSCTL_OFF) / 4; u += NTHR) ((LAS unsigned*)(F.lds + LDSCTL_OFF))[u] = 0u;
    __syncthreads();
    XcdBarrier bar; bar.bar = F.ctl + CW_BAR; bar.x = 0; bar.st = nullptr;
    if (!MK_PER_PHASE) bar = xcd_barrier_post(F.ctl + CW_BAR, MISC + 8);
    const int lo = args.ph_lo, hi = args.ph_hi;
#define IN(k) (lo <= (k) && (k) < hi)
#define SEAM(k) do { if (IN(k) && IN((k) + 1)) xcd_barrier(bar); } while (0)
    if (IN(0)) { ph_wconv_small(F); ph_ln0(F); }
    SEAM(0);
    if (IN(1)) { if (FAST_PROJ) ph_proj_fast(F); else ph_proj(F); }
    SEAM(1);
    if (IN(2)) { ph_prep(F); ph_zstat(F); }
    SEAM(2);
    if (IN(3)) ph_gmlp(F);
    SEAM(3);
    if (IN(4)) { if (FAST_WKV) ph_wkv1(F); else ph_wkv_naive(F); }
    SEAM(4);
    if (IN(5)) { if (FAST_WKV) ph_wkv2(F); }
    SEAM(5);
    if (IN(6)) { if (FAST_WKV) ph_wkv3(F); }
    SEAM(6);
    if (IN(7)) { if (FAST_WOUT) ph_wout_fast(F); else ph_wout(F); }
    SEAM(7);
    if (IN(8)) ph_rowln(F, F.in[I_LN1G], F.in[I_LN1B], (bf16*)(F.ws + WS_X1B));
    SEAM(8);
    if (IN(9)) { ph_route(F); ph_wconv_exp(F); }
    SEAM(9);
    if (IN(10)) ph_bucket(F);
    SEAM(10);
    if (IN(11)) { if (FAST_UP) ph_up_fast(F); else ph_up(F); }
    SEAM(11);
    if (IN(12)) { if (FAST_DOWN) ph_down_fast(F); else ph_down(F); }
    SEAM(12);
    if (IN(13)) { if (FAST_PP) ph_pproj_fast(F); else ph_pproj(F); }
    SEAM(13);
    if (IN(14)) { if (FAST_GATE) ph_gate_fast(F); else ph_gate(F); }
    SEAM(14);
    if (IN(15)) ph_rowln(F, F.in[I_LN2G], F.in[I_LN2B], nullptr);
#undef IN
#undef SEAM
}

extern "C" void kernel_launch(void* const* d_in, const int* in_sizes, int n_in, void* d_out, int out_size, void* d_ws, size_t ws_size, hipStream_t stream) {
    static int grid = 0;
    if (grid == 0) {
        if (n_in != 35 || out_size != T * D || ws_size < WS_END) { fprintf(stderr, "kernel_launch: unexpected shapes n_in %d out %d ws %zu (need %zu)\n", n_in, out_size, ws_size, (size_t)WS_END); grid = -1; return; }
        int dev = 0, cus = 0, per_cu = 0;
        if (hipGetDevice(&dev) != hipSuccess || hipDeviceGetAttribute(&cus, hipDeviceAttributeMultiprocessorCount, dev) != hipSuccess) { grid = -1; return; }
        if (hipFuncSetAttribute((const void*)mk_fwd, hipFuncAttributeMaxDynamicSharedMemorySize, LDS_BYTES) != hipSuccess) { fprintf(stderr, "kernel_launch: hipFuncSetAttribute failed\n"); grid = -1; return; }
        if (hipOccupancyMaxActiveBlocksPerMultiprocessor(&per_cu, (const void*)mk_fwd, NTHR, LDS_BYTES) != hipSuccess || per_cu < 1) fprintf(stderr, "kernel_launch: occupancy query says %d\n", per_cu);
        (void)hipGetLastError();
        grid = cus;
    }
    if (grid < 0) return;
    if (hipMemsetAsync((char*)d_ws + WS_CTL, 0, CTL_ZERO_BYTES, stream) != hipSuccess) return;
    Args a{};
    for (int i = 0; i < 35; ++i) a.in[i] = (const float*)d_in[i];
    a.out = (float*)d_out; a.ws = (unsigned char*)d_ws;
#if MK_PER_PHASE
    for (int ph = 0; ph < NPHASE - 1; ++ph) { a.ph_lo = ph; a.ph_hi = ph + 1; hipLaunchKernelGGL(mk_fwd, dim3(grid), dim3(NTHR), LDS_BYTES, stream, a); }
#else
    a.ph_lo = 0; a.ph_hi = NPHASE; hipLaunchKernelGGL(mk_fwd, dim3(grid), dim3(NTHR), LDS_BYTES, stream, a);
#endif
}
```

```cpp
#include <hip/hip_runtime.h>
#include <cstdio>
#include <cstdint>

#ifndef REP_PH
#define REP_PH -1
#endif
#ifndef REP_N
#define REP_N 1
#endif
#ifndef FAST_WKV
#define FAST_WKV 1
#endif
#ifndef FAST_PROJ
#define FAST_PROJ 1
#endif
#ifndef FAST_WOUT
#define FAST_WOUT 1
#endif
#ifndef FAST_UP
#define FAST_UP 1
#endif
#ifndef FAST_DOWN
#define FAST_DOWN 1
#endif
#ifndef FAST_PP
#define FAST_PP 1
#endif
#ifndef FAST_GATE
#define FAST_GATE 1
#endif
#ifndef MK_PER_PHASE
#define MK_PER_PHASE 0
#endif

constexpr int BATCH = 4, SEQ = 4096, T = BATCH * SEQ, D = 1024, DIN = 2816, NSH = 1792, DR = 512, NH = 8, HD = 64;
constexpr int DG = 512, GG = 4, GW = 128, CH = 128, NE = 32, DE = 512, DP = 256;
constexpr int NSLOT = 40960;
constexpr int NTILE256 = NSLOT / 256;
constexpr float ALPHA = 1.189207115f, LN_EPS = 1e-5f, GN_EPS = 64e-5f, DECAY_SCALE = 0.6065306597f;

constexpr size_t MiB = 1u << 20;
constexpr size_t WS_CTL = 0, CTL_ZERO_BYTES = 1 * MiB;
constexpr size_t WS_STAT0 = 1 * MiB;
constexpr size_t WS_ZSTAT = WS_STAT0 + 128 * 1024;
constexpr size_t WS_TOKE = WS_ZSTAT + 512 * 1024;
constexpr size_t WS_TOKW = WS_TOKE + 128 * 1024;
constexpr size_t WS_TOKP = WS_TOKW + 128 * 1024;
constexpr size_t WS_SLOTTOK = WS_TOKP + 128 * 1024;
constexpr size_t WS_TILEE = WS_SLOTTOK + 256 * 1024;
constexpr size_t WS_WIN_T = 4 * MiB;
constexpr size_t WS_WOUT_T = 10 * MiB, WS_WPG_T = 12 * MiB, WS_WPP_T = 14 * MiB, WS_WLORA_T = 15 * MiB;
constexpr size_t WS_XN = 16 * MiB;
constexpr size_t WS_CAT = 16 * MiB;
constexpr size_t WS_PROJ = 48 * MiB;
constexpr size_t WS_LIN = 136 * MiB;
constexpr size_t WS_LW = 144 * MiB, WS_ICLR = 160 * MiB, WS_G = 176 * MiB;
constexpr size_t WS_CM = 192 * MiB, WS_CN = 208 * MiB, WS_CP = 224 * MiB, WS_CY = 240 * MiB, WS_CH = 256 * MiB, WS_CC = 272 * MiB;
constexpr size_t WS_X1B = 16 * MiB;
constexpr size_t WS_X1L = 48 * MiB;
constexpr size_t WS_LOG = 184 * MiB;
constexpr size_t WS_WR_T = 14 * MiB + 512 * 1024;
constexpr size_t WS_WGU_T = 48 * MiB;
constexpr size_t WS_WD_T = 112 * MiB;
constexpr size_t WS_HID = 144 * MiB;
constexpr size_t WS_Y = 184 * MiB;
constexpr size_t WS_PB = 264 * MiB;
constexpr size_t WS_PP = 144 * MiB;
constexpr size_t WS_END = 284 * MiB;
constexpr int CW_TMO = 0, CW_CODE = 1;
constexpr int CW_ECNT = 1024;
constexpr int CW_NTILES = 1100;
constexpr int CW_BAR = 4096;

constexpr int NWAVES = 8, NTHR = 512;
constexpr int RING_BYTES = 131072, LDSCTL_OFF = RING_BYTES, MISC_OFF = LDSCTL_OFF + 320, LDS_BYTES = 147456;

#define GAS __attribute__((address_space(1)))
#define LAS __attribute__((address_space(3)))
typedef unsigned short bf16;
typedef GAS unsigned gu32;
#define RLX_AGENT __ATOMIC_RELAXED, __HIP_MEMORY_SCOPE_AGENT

__device__ __forceinline__ float bf2f(bf16 v) { return __uint_as_float(((unsigned)v) << 16); }
__device__ __forceinline__ bf16 f2bf(float f) { unsigned u = __float_as_uint(f); return (bf16)((u + 0x7fffu + ((u >> 16) & 1u)) >> 16); }
__device__ __forceinline__ float wave_sum(float v) {
#pragma unroll
    for (int o = 1; o < 64; o <<= 1) v += __shfl_xor(v, o);
    return v;
}
__device__ __forceinline__ float sigmoidf_(float x) { return 1.0f / (1.0f + __expf(-x)); }

#define XB_TMO      128
#define XB_XCNT(j)  (256  + 64 * (j))
#define XB_XSUB(j)  (1280 + 64 * (j))
#define XB_XGEN(j)  (2304 + 64 * (j))
#define XB_TOP      3328
#define XB_TOPGEN   3392
#define XCD_BAR_WORDS 3456
#define XB_SPIN_CAP (1u << 18)
__device__ __forceinline__ unsigned xb_ld(unsigned* p)              { return __hip_atomic_load(p, __ATOMIC_RELAXED, __HIP_MEMORY_SCOPE_AGENT); }
__device__ __forceinline__ unsigned xb_add(unsigned* p, unsigned v) { return __hip_atomic_fetch_add(p, v, __ATOMIC_RELAXED, __HIP_MEMORY_SCOPE_AGENT); }
__device__ __forceinline__ unsigned xb_xcc_id() { return (unsigned)__builtin_amdgcn_s_getreg((3 << 11) | 20) & 0xFu; }
#define XB_SPIN(cond, bar) do { unsigned _sp = 0; while (cond) { __builtin_amdgcn_s_sleep(1); \
    if ((++_sp & 255u) == 0u) { if (xb_ld(&(bar)[XB_TMO])) break; if (_sp > XB_SPIN_CAP) { atomicAdd(&(bar)[XB_TMO], 1u); break; } } } } while (0)
struct XcdBarrier { unsigned* bar; unsigned x; volatile LAS unsigned* st; };
__device__ __forceinline__ XcdBarrier xcd_barrier_post(unsigned* bar, volatile LAS unsigned* st) {
    XcdBarrier b; b.bar = bar; b.x = xb_xcc_id(); b.st = st;
    if (threadIdx.x == 0) (void)xb_add(&bar[XB_XCNT(b.x)], 1u);
    return b;
}
__device__ __forceinline__ void xcd_barrier_complete(unsigned* bar, unsigned x, unsigned& nloc, unsigned& nx) {
    const unsigned G = gridDim.x * gridDim.y * gridDim.z;
    unsigned sum, cnt, mine, sp = 0u;
    for (;;) {
        sum = 0u; cnt = 0u; mine = 0u;
#pragma unroll
        for (unsigned j = 0; j < 16; ++j) { const unsigned c = xb_ld(&bar[XB_XCNT(j)]); sum += c; cnt += (c > 0u) ? 1u : 0u; mine = (j == x) ? c : mine; }
        if (sum == G) break;
        __builtin_amdgcn_s_sleep(1);
        if ((++sp & 255u) == 0u) { if (xb_ld(&bar[XB_TMO])) break; if (sp > XB_SPIN_CAP) { atomicAdd(&bar[XB_TMO], 1u); break; } }
    }
    nloc = mine > 0u ? mine : 1u; nx = cnt > 0u ? cnt : 1u;
}
__device__ __forceinline__ void xcd_barrier(const XcdBarrier& b) {
    asm volatile("s_waitcnt vmcnt(0)" ::: "memory");
    __syncthreads();
    if (threadIdx.x == 0) {
        unsigned* bar = b.bar;
        __builtin_amdgcn_s_waitcnt(0);
        unsigned nloc = b.st[0], nx = b.st[1];
        if (nloc == 0u) { xcd_barrier_complete(bar, b.x, nloc, nx); b.st[0] = nloc; b.st[1] = nx; }
        const unsigned old = xb_add(&bar[XB_XSUB(b.x)], 1u);
        const unsigned gen = old / nloc;
        if (old + 1u == (gen + 1u) * nloc) {
            __builtin_amdgcn_fence(__ATOMIC_RELEASE, "agent");
            asm volatile("s_waitcnt vmcnt(0)" ::: "memory");
            const unsigned og = xb_add(&bar[XB_TOP], 1u);
            const unsigned tg = og / nx;
            if (og + 1u == (tg + 1u) * nx) xb_add(&bar[XB_TOPGEN], 1u);
            else XB_SPIN(xb_ld(&bar[XB_TOPGEN]) == tg, bar);
            __builtin_amdgcn_fence(__ATOMIC_ACQUIRE, "agent");
            xb_add(&bar[XB_XGEN(b.x)], 1u);
            asm volatile("s_waitcnt vmcnt(0)" ::: "memory");
        } else {
            XB_SPIN(xb_ld(&bar[XB_XGEN(b.x)]) == gen, bar);
            __builtin_amdgcn_fence(__ATOMIC_ACQUIRE, "agent");
            asm volatile("s_waitcnt vmcnt(0)" ::: "memory");
        }
    }
    __syncthreads();
}

struct Frame {
    LAS unsigned char* lds;
    float* sm;
    unsigned* ctl;
    int tid, lane, wave, G, bid;
    const float* in[35];
    float* out;
    unsigned char* ws;
};
enum { I_X = 0, I_P, I_LNEG, I_LNEB, I_WIN, I_MU, I_W0, I_WDEC, I_A0, I_WICLR, I_WGATE, I_KK, I_KA, I_RK, I_GNG, I_GNB, I_GLNG, I_GLNB, I_WSP, I_BSP,
       I_WOUT, I_LN1G, I_LN1B, I_WGR, I_BGR, I_WER, I_BER, I_WEG, I_WEU, I_WED, I_WPG, I_BPG, I_WPP, I_LN2G, I_LN2B };

template <class AF, class BF, class EF>
__device__ __forceinline__ void sgemm_tile(float* sA, float* sB, int tid, int m0, int n0, int K, AF af, BF bf, EF ef) {
    const int tx = tid & 15, ty = tid >> 4;
    float acc[4][4];
#pragma unroll
    for (int i = 0; i < 4; ++i)
#pragma unroll
        for (int j = 0; j < 4; ++j) acc[i][j] = 0.f;
    for (int k0 = 0; k0 < K; k0 += 16) {
        float ra[4], rb[2];
#pragma unroll
        for (int i = 0; i < 4; ++i) { const int idx = tid + i * 512, m = idx >> 4, k = idx & 15; ra[i] = af(m0 + m, k0 + k); }
#pragma unroll
        for (int i = 0; i < 2; ++i) { const int idx = tid + i * 512, k = idx >> 6, n = idx & 63; rb[i] = bf(k0 + k, n0 + n); }
        __syncthreads();
#pragma unroll
        for (int i = 0; i < 4; ++i) { const int idx = tid + i * 512, m = idx >> 4, k = idx & 15; sA[k * 132 + m] = ra[i]; }
#pragma unroll
        for (int i = 0; i < 2; ++i) { const int idx = tid + i * 512, k = idx >> 6, n = idx & 63; sB[k * 68 + n] = rb[i]; }
        __syncthreads();
#pragma unroll
        for (int k = 0; k < 16; ++k) {
            const float4 a = *(const float4*)(sA + k * 132 + ty * 4), b = *(const float4*)(sB + k * 68 + tx * 4);
            const float av[4] = {a.x, a.y, a.z, a.w}, bv[4] = {b.x, b.y, b.z, b.w};
#pragma unroll
            for (int i = 0; i < 4; ++i)
#pragma unroll
                for (int j = 0; j < 4; ++j) acc[i][j] = fmaf(av[i], bv[j], acc[i][j]);
        }
    }
    ef(m0 + ty * 4, n0 + tx * 4, acc);
    __syncthreads();
}

__device__ __forceinline__ void ph_ln0(Frame& F) {
    const float* x = F.in[I_X]; const float* g = F.in[I_LNEG]; const float* b = F.in[I_LNEB];
    bf16* XN = (bf16*)(F.ws + WS_XN); float* st = (float*)(F.ws + WS_STAT0);
    const int gw = F.bid * NWAVES + F.wave, NGW = F.G * NWAVES;
    for (int m = gw; m < T; m += NGW) {
        const float* xr = x + (size_t)m * D; float v[16]; float s = 0.f;
#pragma unroll
        for (int j = 0; j < 16; ++j) { v[j] = xr[F.lane + 64 * j]; s += v[j]; }
        const float mean = wave_sum(s) * (1.f / D); float q = 0.f;
#pragma unroll
        for (int j = 0; j < 16; ++j) { const float d = v[j] - mean; q += d * d; }
        const float rstd = 1.0f / sqrtf(wave_sum(q) * (1.f / D) + LN_EPS);
#pragma unroll
        for (int j = 0; j < 16; ++j) { const int c = F.lane + 64 * j; XN[(size_t)m * D + c] = f2bf((v[j] - mean) * rstd * g[c] + b[c]); }
        if (F.lane == 0) { st[2 * m] = mean; st[2 * m + 1] = rstd; }
    }
}
__device__ __forceinline__ void ph_proj(Frame& F) {
    const bf16* XN = (const bf16*)(F.ws + WS_XN); const float* W = F.in[I_WIN]; bf16* PR = (bf16*)(F.ws + WS_PROJ);
    float* sA = F.sm; float* sB = F.sm + 16 * 132;
    const int ntn = DIN / 64, ntm = T / 128;
    for (int tile = F.bid; tile < ntm * ntn; tile += F.G) {
        const int m0 = (tile / ntn) * 128, n0 = (tile % ntn) * 64;
        sgemm_tile(sA, sB, F.tid, m0, n0, D,
            [&](int m, int k) { return bf2f(XN[(size_t)m * D + k]); },
            [&](int k, int n) { return W[(size_t)k * DIN + n]; },
            [&](int mb, int nb, float (&acc)[4][4]) {
#pragma unroll
                for (int i = 0; i < 4; ++i)
#pragma unroll
                    for (int j = 0; j < 4; ++j) { float v = acc[i][j]; const int n = nb + j; if (n >= NSH) v = 0.5f * v * (1.0f + erff(v * 0.70710678f)); PR[(size_t)(mb + i) * DIN + n] = f2bf(v); }
            });
    }
}
__device__ __forceinline__ void ph_zstat(Frame& F) {
    const bf16* PR = (const bf16*)(F.ws + WS_PROJ); float* zs = (float*)(F.ws + WS_ZSTAT);
    const int gw = F.bid * NWAVES + F.wave, NGW = F.G * NWAVES;
    for (int it = gw; it < T * GG; it += NGW) {
        const int t = it >> 2, g = it & 3; const bf16* p = PR + (size_t)t * DIN + NSH + DG + g * GW;
        const float a = bf2f(p[F.lane]), b = bf2f(p[F.lane + 64]);
        const float mean = wave_sum(a + b) * (1.f / GW); const float da = a - mean, db = b - mean;
        const float rstd = 1.0f / sqrtf(wave_sum(da * da + db * db) * (1.f / GW) + LN_EPS);
        if (F.lane == 0) { zs[2 * it] = mean; zs[2 * it + 1] = rstd; }
    }
}
__device__ __forceinline__ void ph_gmlp(Frame& F) {
    const bf16* PR = (const bf16*)(F.ws + WS_PROJ); const float* zs = (const float*)(F.ws + WS_ZSTAT);
    const float* lg = F.in[I_GLNG]; const float* lb = F.in[I_GLNB]; const float* wsp = F.in[I_WSP]; const float* bsp = F.in[I_BSP];
    bf16* CAT = (bf16*)(F.ws + WS_CAT);
    const int c = F.tid, g = c >> 7; const float gg = lg[c], gb = lb[c];
    for (int t = F.bid; t < T; t += F.G) {
        const int tl = t & (CH - 1), t0 = t - tl; const float* wrow = wsp + ((size_t)g * CH + tl) * CH;
        float acc = bsp[g * CH + tl];
        for (int sl = 0; sl <= tl; ++sl) {
            const int s = t0 + sl; const float zv = bf2f(PR[(size_t)s * DIN + NSH + DG + c]);
            const float zn = (zv - zs[(s * 4 + g) * 2]) * zs[(s * 4 + g) * 2 + 1] * gg + gb;
            acc = fmaf(wrow[sl], zn, acc);
        }
        const float zu = bf2f(PR[(size_t)t * DIN + NSH + c]);
        CAT[(size_t)t * D + DR + c] = f2bf(zu * acc);
    }
}
__device__ __forceinline__ void ph_wout(Frame& F) {
    const bf16* CAT = (const bf16*)(F.ws + WS_CAT); const float* W = F.in[I_WOUT]; const float* x = F.in[I_X]; const float* st = (const float*)(F.ws + WS_STAT0);
    const float* g = F.in[I_LNEG]; const float* b = F.in[I_LNEB]; float* out = F.out;
    float* sA = F.sm; float* sB = F.sm + 16 * 132;
    const int ntn = D / 64, ntm = T / 128;
    for (int tile = F.bid; tile < ntm * ntn; tile += F.G) {
        const int m0 = (tile / ntn) * 128, n0 = (tile % ntn) * 64;
        sgemm_tile(sA, sB, F.tid, m0, n0, D,
            [&](int m, int k) { return bf2f(CAT[(size_t)m * D + k]); },
            [&](int k, int n) { return W[(size_t)k * D + n]; },
            [&](int mb, int nb, float (&acc)[4][4]) {
#pragma unroll
                for (int i = 0; i < 4; ++i) { const int m = mb + i; const float mean = st[2 * m], rstd = st[2 * m + 1];
#pragma unroll
                    for (int j = 0; j < 4; ++j) { const int n = nb + j; const float xn = (x[(size_t)m * D + n] - mean) * rstd * g[n] + b[n]; out[(size_t)m * D + n] = ALPHA * xn + acc[i][j]; } }
            });
    }
}
__device__ __forceinline__ void ph_rowln(Frame& F, const float* g, const float* b, bf16* xb, bf16* xl) {
    float* out = F.out;
    const int gw = F.bid * NWAVES + F.wave, NGW = F.G * NWAVES;
    for (int m = gw; m < T; m += NGW) {
        float* xr = out + (size_t)m * D; float v[16]; float s = 0.f;
#pragma unroll
        for (int j = 0; j < 16; ++j) { v[j] = xr[F.lane + 64 * j]; s += v[j]; }
        const float mean = wave_sum(s) * (1.f / D); float q = 0.f;
#pragma unroll
        for (int j = 0; j < 16; ++j) { const float d = v[j] - mean; q += d * d; }
        const float rstd = 1.0f / sqrtf(wave_sum(q) * (1.f / D) + LN_EPS);
#pragma unroll
        for (int j = 0; j < 16; ++j) { const int c = F.lane + 64 * j; const float o = (v[j] - mean) * rstd * g[c] + b[c]; xr[c] = o; if (xb) { const bf16 hb = f2bf(o); xb[(size_t)m * D + c] = hb; xl[(size_t)m * D + c] = f2bf(o - bf2f(hb)); } }
    }
}
__device__ __forceinline__ void ph_route(Frame& F) {
    const float* x1 = F.out; const float* Wgr = F.in[I_WGR]; const float* bgr = F.in[I_BGR]; const float* Wer = F.in[I_WER]; const float* ber = F.in[I_BER];
    int* tokE = (int*)(F.ws + WS_TOKE); float* tokW = (float*)(F.ws + WS_TOKW); int* tokP = (int*)(F.ws + WS_TOKP); int* slotTok = (int*)(F.ws + WS_SLOTTOK);
    unsigned* ecnt = F.ctl + CW_ECNT;
    for (int i = F.bid * NTHR + F.tid; i < NSLOT; i += F.G * NTHR) slotTok[i] = -1;
    const int gw = F.bid * NWAVES + F.wave, NGW = F.G * NWAVES;
    for (int t = gw; t < T; t += NGW) {
        const float* xr = x1 + (size_t)t * D; float acc = 0.f; const int o = F.lane;
        if (o < 4) { for (int k = 0; k < D; ++k) acc = fmaf(xr[k], Wgr[k * 4 + o], acc); acc += bgr[o]; }
        else if (o < 36) { for (int k = 0; k < D; ++k) acc = fmaf(xr[k], Wer[k * 32 + (o - 4)], acc); acc += ber[o - 4]; }
        float gl[4];
#pragma unroll
        for (int j = 0; j < 4; ++j) gl[j] = __shfl(acc, j);
        int gs = 0; float gm = gl[0];
#pragma unroll
        for (int j = 1; j < 4; ++j) if (gl[j] > gm) { gm = gl[j]; gs = j; }
        float se = 0.f;
#pragma unroll
        for (int j = 0; j < 4; ++j) se += __expf(gl[j] - gm);
        const float pg = 1.0f / se;
        float el[8];
#pragma unroll
        for (int j = 0; j < 8; ++j) el[j] = __shfl(acc, 4 + gs * 8 + j);
        int i1 = 0; float v1 = el[0];
#pragma unroll
        for (int j = 1; j < 8; ++j) if (el[j] > v1) { v1 = el[j]; i1 = j; }
        int i2 = -1; float v2 = -3.0e38f;
#pragma unroll
        for (int j = 0; j < 8; ++j) if (j != i1 && el[j] > v2) { v2 = el[j]; i2 = j; }
        const float e2 = __expf(v2 - v1), w1 = pg / (1.0f + e2), w2 = pg * e2 / (1.0f + e2);
        if (F.lane == 0) {
            const int ea = gs * 8 + i1, eb = gs * 8 + i2;
            tokE[2 * t] = ea; tokE[2 * t + 1] = eb; tokW[2 * t] = w1; tokW[2 * t + 1] = w2;
            tokP[2 * t] = (int)atomicAdd(&ecnt[ea], 1u); tokP[2 * t + 1] = (int)atomicAdd(&ecnt[eb], 1u);
        }
    }
}
__device__ __forceinline__ void ph_bucket(Frame& F) {
    int* tokE = (int*)(F.ws + WS_TOKE); int* tokP = (int*)(F.ws + WS_TOKP); int* slotTok = (int*)(F.ws + WS_SLOTTOK); int* tileE = (int*)(F.ws + WS_TILEE);
    unsigned* ecnt = F.ctl + CW_ECNT;
    int* pstart = (int*)F.sm;
    __syncthreads();
    if (F.tid == 0) { int s = 0; for (int e = 0; e < NE; ++e) { pstart[e] = s; s += (((int)xb_ld(&ecnt[e]) + 255) / 256) * 256; } pstart[NE] = s; }
    __syncthreads();
    if (F.bid == 0 && F.tid == 0) __hip_atomic_store(F.ctl + CW_NTILES, (unsigned)(pstart[NE] / 256), RLX_AGENT);
    if (F.bid == 0) for (int tl = F.tid; tl < NTILE256; tl += NTHR) { int e = -1; for (int j = 0; j < NE; ++j) if (tl * 256 >= pstart[j] && tl * 256 < pstart[j + 1]) e = j; tileE[tl] = e; }
    for (int i = F.bid * NTHR + F.tid; i < 2 * T; i += F.G * NTHR) { const int slot = pstart[tokE[i]] + tokP[i]; tokP[i] = slot; slotTok[slot] = i >> 1; }
    __syncthreads();
}
__device__ __forceinline__ void ph_up(Frame& F) {
    const bf16* X1B = (const bf16*)(F.ws + WS_X1B); const float* Weg = F.in[I_WEG]; const float* Weu = F.in[I_WEU]; bf16* HID = (bf16*)(F.ws + WS_HID);
    const int* slotTok = (const int*)(F.ws + WS_SLOTTOK); const int* tileE = (const int*)(F.ws + WS_TILEE);
    float* sA = F.sm; float* sB = F.sm + 16 * 132;
    const int ntn = (2 * DE) / 64, ntm = NSLOT / 128;
    for (int tile = F.bid; tile < ntm * ntn; tile += F.G) {
        const int m0 = (tile / ntn) * 128, n0 = (tile % ntn) * 64; const int e = tileE[m0 >> 8];
        if (e < 0) continue;
        const float* wg = Weg + (size_t)e * D * DE; const float* wu = Weu + (size_t)e * D * DE;
        sgemm_tile(sA, sB, F.tid, m0, n0, D,
            [&](int m, int k) { const int tk = slotTok[m]; return tk >= 0 ? bf2f(X1B[(size_t)tk * D + k]) : 0.f; },
            [&](int k, int n) { return (n & 1) ? wu[(size_t)k * DE + (n >> 1)] : wg[(size_t)k * DE + (n >> 1)]; },
            [&](int mb, int nb, float (&acc)[4][4]) {
#pragma unroll
                for (int i = 0; i < 4; ++i)
#pragma unroll
                    for (int j = 0; j < 2; ++j) { const float gt = acc[i][2 * j], up = acc[i][2 * j + 1]; HID[(size_t)(mb + i) * DE + (nb >> 1) + j] = f2bf(gt * sigmoidf_(gt) * up); }
            });
    }
}
__device__ __forceinline__ void ph_down(Frame& F) {
    const bf16* HID = (const bf16*)(F.ws + WS_HID); const float* Wed = F.in[I_WED]; bf16* Y = (bf16*)(F.ws + WS_Y);
    const int* tileE = (const int*)(F.ws + WS_TILEE);
    float* sA = F.sm; float* sB = F.sm + 16 * 132;
    const int ntn = D / 64, ntm = NSLOT / 128;
    for (int tile = F.bid; tile < ntm * ntn; tile += F.G) {
        const int m0 = (tile / ntn) * 128, n0 = (tile % ntn) * 64; const int e = tileE[m0 >> 8];
        if (e < 0) continue;
        const float* wd = Wed + (size_t)e * DE * D;
        sgemm_tile(sA, sB, F.tid, m0, n0, DE,
            [&](int m, int k) { return bf2f(HID[(size_t)m * DE + k]); },
            [&](int k, int n) { return wd[(size_t)k * D + n]; },
            [&](int mb, int nb, float (&acc)[4][4]) {
#pragma unroll
                for (int i = 0; i < 4; ++i)
#pragma unroll
                    for (int j = 0; j < 4; ++j) Y[(size_t)(mb + i) * D + nb + j] = f2bf(acc[i][j]);
            });
    }
}
__device__ __forceinline__ void ph_pproj(Frame& F) {
    const float* P = F.in[I_P]; const float* W = F.in[I_WPP]; bf16* PP = (bf16*)(F.ws + WS_PP);
    float* sA = F.sm; float* sB = F.sm + 16 * 132;
    const int ntn = D / 64, ntm = T / 128;
    for (int tile = F.bid; tile < ntm * ntn; tile += F.G) {
        const int m0 = (tile / ntn) * 128, n0 = (tile % ntn) * 64;
        sgemm_tile(sA, sB, F.tid, m0, n0, DP,
            [&](int m, int k) { return P[(size_t)m * DP + k]; },
            [&](int k, int n) { return W[(size_t)k * D + n]; },
            [&](int mb, int nb, float (&acc)[4][4]) {
#pragma unroll
                for (int i = 0; i < 4; ++i)
#pragma unroll
                    for (int j = 0; j < 4; ++j) PP[(size_t)(mb + i) * D + nb + j] = f2bf(acc[i][j]);
            });
    }
}
__device__ __forceinline__ void ph_gate(Frame& F) {
    const bf16* X1B = (const bf16*)(F.ws + WS_X1B); const float* W = F.in[I_WPG]; const float* bpg = F.in[I_BPG]; const bf16* PP = (const bf16*)(F.ws + WS_PP); const bf16* Y = (const bf16*)(F.ws + WS_Y);
    const int* tokP = (const int*)(F.ws + WS_TOKP); const float* tokW = (const float*)(F.ws + WS_TOKW); float* out = F.out;
    float* sA = F.sm; float* sB = F.sm + 16 * 132;
    const int ntn = D / 64, ntm = T / 128;
    for (int tile = F.bid; tile < ntm * ntn; tile += F.G) {
        const int m0 = (tile / ntn) * 128, n0 = (tile % ntn) * 64;
        sgemm_tile(sA, sB, F.tid, m0, n0, D,
            [&](int m, int k) { return bf2f(X1B[(size_t)m * D + k]); },
            [&](int k, int n) { return W[(size_t)k * D + n]; },
            [&](int mb, int nb, float (&acc)[4][4]) {
#pragma unroll
                for (int i = 0; i < 4; ++i) { const int m = mb + i; const int s0 = tokP[2 * m], s1 = tokP[2 * m + 1]; const float w0 = tokW[2 * m], w1 = tokW[2 * m + 1];
#pragma unroll
                    for (int j = 0; j < 4; ++j) { const int n = nb + j; const size_t o = (size_t)m * D + n;
                        const float ffn = w0 * bf2f(Y[(size_t)s0 * D + n]) + w1 * bf2f(Y[(size_t)s1 * D + n]);
                        out[o] = ALPHA * out[o] + ffn + sigmoidf_(acc[i][j] + bpg[n]) * bf2f(PP[o]); } }
            });
    }
}


namespace pg8 {
#define PG8_LAS __attribute__((address_space(3)))
typedef unsigned short bf16_t;
typedef short bf16x8 __attribute__((ext_vector_type(8)));
typedef float f32x4 __attribute__((ext_vector_type(4)));
typedef float f32x2 __attribute__((ext_vector_type(2)));
typedef unsigned u32x4 __attribute__((ext_vector_type(4)));
typedef unsigned u32x2 __attribute__((ext_vector_type(2)));
constexpr int BM = 256, BK = 64, HALF = 128, HTB = HALF * BK * 2, STAGE_BYTES = 8 * HTB, NXCD = 8, WGM = 8;
__host__ __device__ __forceinline__ int lds_byte(int r, int c) { const int st = (r >> 4) * 2 + (c >> 5), rr = r & 15, cc = c & 31, ob = rr * 64 + cc * 2; return st * 1024 + (ob ^ (((ob >> 9) & 1) << 5)); }
__host__ __device__ __forceinline__ void stage_rc(int b, int& R, int& C) { const int st = b / 1024, sb = b % 1024, swz = sb ^ (((sb >> 9) & 1) << 5); R = (st >> 1) * 16 + swz / 64; C = (st & 1) * 32 + (swz % 64) / 2; }
__host__ __device__ __forceinline__ int perm32(int rho) { const int n = rho >> 4, i = rho & 15; return 8 * (i >> 2) + 4 * n + (i & 3); }
struct Unit { int pm, pn; };

struct OrdStd {
    const char* A; const char* Bt; int K; int nM, nN, nwg, G, c;
    __device__ __forceinline__ void init(const void* A_, const void* Bt_, int M, int N, int K_, int G_, int c_) { A = (const char*)A_; Bt = (const char*)Bt_; K = K_; nM = M / BM; nN = N / BM; nwg = nM * nN; G = G_; c = c_; }
    __device__ __forceinline__ bool next(int i, Unit& u) const {
        const long L = (long)i * G + c; if (L >= nwg) return false;
        int wgid = (int)L; { const int q = nwg / NXCD, r = nwg % NXCD, xcd = wgid % NXCD, off = wgid / NXCD; wgid = (xcd < r ? xcd * (q + 1) : r * (q + 1) + (xcd - r) * q) + off; }
        const int nig = WGM * nN, gid = wgid / nig, fm = gid * WGM, gsz = (nM - fm) < WGM ? (nM - fm) : WGM;
        u.pm = fm + ((wgid % nig) % gsz); u.pn = (wgid % nig) / gsz; return true;
    }
    __device__ __forceinline__ const char* a_ptr(const Unit& u) const { return A + (size_t)u.pm * BM * K * 2; }
    __device__ __forceinline__ const char* b_ptr(const Unit& u) const { return Bt + (size_t)u.pn * BM * K * 2; }
    __device__ __forceinline__ void a_off(const Unit&, const int (&R)[2], const int (&C)[2], unsigned (&v)[2][2]) const {
#pragma unroll
        for (int h = 0; h < 2; ++h)
#pragma unroll
            for (int i = 0; i < 2; ++i) v[h][i] = (unsigned)((R[i] + HALF * h) * K + C[i]) * 2u;
    }
};
template <bool GATHER> struct OrdExp {
    const char* A; const char* Bt; int K; const int* slotTok; const int* tileE; int ntiles, G, c; size_t estride;
    __device__ __forceinline__ bool next(int i, Unit& u) const { const int L = i * G + c; if (L >= ntiles * 4) return false; u.pm = L >> 2; u.pn = L & 3; return true; }
    __device__ __forceinline__ const char* a_ptr(const Unit& u) const { return GATHER ? A : A + (size_t)u.pm * BM * K * 2; }
    __device__ __forceinline__ const char* b_ptr(const Unit& u) const { const int e = tileE[u.pm]; return Bt + (size_t)e * estride + (size_t)u.pn * BM * K * 2; }
    __device__ __forceinline__ void a_off(const Unit& u, const int (&R)[2], const int (&C)[2], unsigned (&v)[2][2]) const {
#pragma unroll
        for (int h = 0; h < 2; ++h)
#pragma unroll
            for (int i = 0; i < 2; ++i) {
                int row = R[i] + HALF * h;
                if (GATHER) { row = slotTok[u.pm * BM + row]; row = row < 0 ? 0 : row; }
                v[h][i] = (unsigned)(row * K + C[i]) * 2u;
            }
    }
};

typedef __bf16 bf16v2_ __attribute__((ext_vector_type(2)));
__device__ __forceinline__ unsigned cvt_pk_bf16(float lo, float hi) { bf16v2_ v = {(__bf16)lo, (__bf16)hi}; return __builtin_bit_cast(unsigned, v); }
__device__ __forceinline__ f32x2 gelu_pk(f32x2 v) {
    const f32x2 av = __builtin_elementwise_abs(v), d = av * 0.2316418882f + 1.0f;
    f32x2 t; t.x = __builtin_amdgcn_rcpf(d.x); t.y = __builtin_amdgcn_rcpf(d.y);
    f32x2 q = t * 0.5307027145f + (-0.7265760135f); q = q * t + 0.7107068705f; q = q * t + (-0.142248368f); q = q * t + 0.127414796f; q = q * t;
    const f32x2 s = (v * v) * (-0.72134752044f);
    f32x2 e; e.x = __builtin_amdgcn_exp2f(s.x); e.y = __builtin_amdgcn_exp2f(s.y);
    const f32x2 m = v * (q * e), r = v - m;
    f32x2 o; o.x = v.x < 0.f ? m.x : r.x; o.y = v.y < 0.f ? m.y : r.y; return o;
}
__device__ __forceinline__ float bfl(unsigned w) { return __uint_as_float(w << 16); }
__device__ __forceinline__ float bfh(unsigned w) { return __uint_as_float(w & 0xffff0000u); }
__device__ __forceinline__ float sigm(float x) { return __builtin_amdgcn_rcpf(1.0f + __expf(-x)); }

struct EpiBf16 {
    static constexpr bool PERM = true;
    bf16_t* O; int ldc; int gelu_from_pn;
    __device__ __forceinline__ void operator()(const f32x4 (&acc)[2][2][4][2], const Unit& u, int wr, int wc, int fr, int fq) const {
        const int row0 = u.pm * BM + wr * 64 + fr, col0 = u.pn * BM + wc * 32 + 8 * fq; const bool act = u.pn >= gelu_from_pn;
#pragma unroll
        for (int ai = 0; ai < 2; ++ai)
#pragma unroll
            for (int m = 0; m < 4; ++m) { bf16_t* rowp = O + (size_t)(row0 + ai * HALF + m * 16) * ldc + col0;
#pragma unroll
                for (int bj = 0; bj < 2; ++bj) { f32x4 v0 = acc[ai][bj][m][0], v1 = acc[ai][bj][m][1];
                    if (act) { f32x2 a = gelu_pk((f32x2){v0[0], v0[1]}), b = gelu_pk((f32x2){v0[2], v0[3]}), c = gelu_pk((f32x2){v1[0], v1[1]}), d = gelu_pk((f32x2){v1[2], v1[3]});
                        v0 = (f32x4){a.x, a.y, b.x, b.y}; v1 = (f32x4){c.x, c.y, d.x, d.y}; }
                    u32x4 w; w.x = cvt_pk_bf16(v0[0], v0[1]); w.y = cvt_pk_bf16(v0[2], v0[3]); w.z = cvt_pk_bf16(v1[0], v1[1]); w.w = cvt_pk_bf16(v1[2], v1[3]);
                    *(u32x4*)(rowp + bj * HALF) = w; } }
    }
};

struct EpiLora {
    static constexpr bool PERM = true;
    bf16_t* LWp; const float* w0; const float* a0;
    __device__ __forceinline__ void operator()(const f32x4 (&acc)[2][2][4][2], const Unit& u, int wr, int wc, int fr, int fq) const {
        const int kind = u.pn >> 1; bf16_t* O = LWp + (size_t)kind * ((WS_ICLR - WS_LW) / 2); const float* bias = kind == 0 ? w0 : a0;
        const int row0 = u.pm * BM + wr * 64 + fr, col0 = (u.pn & 1) * BM + wc * 32 + 8 * fq; const float sc = kind == 0 ? -DECAY_SCALE : 1.0f;
#pragma unroll
        for (int ai = 0; ai < 2; ++ai)
#pragma unroll
            for (int m = 0; m < 4; ++m) { bf16_t* rowp = O + (size_t)(row0 + ai * HALF + m * 16) * DR + col0;
#pragma unroll
                for (int bj = 0; bj < 2; ++bj) { f32x4 v0 = acc[ai][bj][m][0], v1 = acc[ai][bj][m][1];
                    if (kind < 2) { const f32x4 b0 = *(const f32x4*)(bias + col0 + bj * HALF), b1 = *(const f32x4*)(bias + col0 + bj * HALF + 4);
#pragma unroll
                        for (int e = 0; e < 4; ++e) { v0[e] = sc * sigm(v0[e] + b0[e]); v1[e] = sc * sigm(v1[e] + b1[e]); } }
                    u32x4 w; w.x = cvt_pk_bf16(v0[0], v0[1]); w.y = cvt_pk_bf16(v0[2], v0[3]); w.z = cvt_pk_bf16(v1[0], v1[1]); w.w = cvt_pk_bf16(v1[2], v1[3]);
                    *(u32x4*)(rowp + bj * HALF) = w; }
                asm volatile("" ::: "memory"); }
    }
};

struct EpiLog {
    static constexpr bool PERM = false;
    float* out;
    __device__ __forceinline__ void operator()(const f32x4 (&acc)[2][2][4][2], const Unit& u, int wr, int wc, int fr, int fq) const {
        const int col0 = wc * 32 + 4 * fq;
#pragma unroll
        for (int ai = 0; ai < 2; ++ai)
#pragma unroll
            for (int m = 0; m < 4; ++m) { const int row = u.pm * BM + ai * HALF + wr * 64 + m * 16 + fr;
#pragma unroll
                for (int n = 0; n < 2; ++n) *(f32x4*)(out + (size_t)row * 128 + col0 + n * 16) = acc[ai][0][m][n]; }
    }
};
struct EpiUp {
    static constexpr bool PERM = true;
    bf16_t* HIDp;
    __device__ __forceinline__ void operator()(const f32x4 (&acc)[2][2][4][2], const Unit& u, int wr, int wc, int fr, int fq) const {
        const int row0 = u.pm * BM + wr * 64 + fr, hcol0 = u.pn * 128 + wc * 16 + 4 * fq;
#pragma unroll
        for (int ai = 0; ai < 2; ++ai)
#pragma unroll
            for (int m = 0; m < 4; ++m) { bf16_t* rowp = HIDp + (size_t)(row0 + ai * HALF + m * 16) * DE + hcol0;
#pragma unroll
                for (int bj = 0; bj < 2; ++bj) { const f32x4 v0 = acc[ai][bj][m][0], v1 = acc[ai][bj][m][1];
                    const float h0 = v0[0] * sigm(v0[0]) * v0[1], h1 = v0[2] * sigm(v0[2]) * v0[3], h2 = v1[0] * sigm(v1[0]) * v1[1], h3 = v1[2] * sigm(v1[2]) * v1[3];
                    u32x2 w; w.x = cvt_pk_bf16(h0, h1); w.y = cvt_pk_bf16(h2, h3);
                    *(u32x2*)(rowp + bj * 64) = w; } }
    }
};
struct EpiWout {
    static constexpr bool PERM = false;
    const float* x; const float* st; const float* g; const float* b; float* out;
    __device__ __forceinline__ void operator()(const f32x4 (&acc)[2][2][4][2], const Unit& u, int wr, int wc, int fr, int fq) const {
        const int col0 = u.pn * BM + wc * 32 + 4 * fq;
        f32x4 gv[2][2], bv[2][2];
#pragma unroll
        for (int bj = 0; bj < 2; ++bj)
#pragma unroll
            for (int n = 0; n < 2; ++n) { gv[bj][n] = *(const f32x4*)(g + col0 + bj * HALF + n * 16); bv[bj][n] = *(const f32x4*)(b + col0 + bj * HALF + n * 16); }
#pragma unroll
        for (int ai = 0; ai < 2; ++ai)
#pragma unroll
            for (int m = 0; m < 4; ++m) { const int row = u.pm * BM + ai * HALF + wr * 64 + m * 16 + fr; const float mean = st[2 * row], rstd = st[2 * row + 1]; const size_t off = (size_t)row * D + col0;
#pragma unroll
                for (int bj = 0; bj < 2; ++bj)
#pragma unroll
                    for (int n = 0; n < 2; ++n) { const f32x4 xv = *(const f32x4*)(x + off + bj * HALF + n * 16);
                        *(f32x4*)(out + off + bj * HALF + n * 16) = ((xv - mean) * rstd * gv[bj][n] + bv[bj][n]) * ALPHA + acc[ai][bj][m][n]; }
                asm volatile("" ::: "memory"); }
    }
};
struct EpiGate {
    static constexpr bool PERM = false;
    float* out; const bf16_t* Y; const bf16_t* PP; const float* bias; const int* tokP; const float* tokW;
    __device__ __forceinline__ void operator()(const f32x4 (&acc)[2][2][4][2], const Unit& u, int wr, int wc, int fr, int fq) const {
        const int col0 = u.pn * BM + wc * 32 + 4 * fq;
        f32x4 bv[2][2];
#pragma unroll
        for (int bj = 0; bj < 2; ++bj)
#pragma unroll
            for (int n = 0; n < 2; ++n) bv[bj][n] = *(const f32x4*)(bias + col0 + bj * HALF + n * 16);
#pragma unroll
        for (int ai = 0; ai < 2; ++ai)
#pragma unroll
            for (int m = 0; m < 4; ++m) { const int row = u.pm * BM + ai * HALF + wr * 64 + m * 16 + fr; const size_t off = (size_t)row * D + col0;
                const int s0 = tokP[2 * row], s1 = tokP[2 * row + 1]; const float w0 = tokW[2 * row], w1 = tokW[2 * row + 1];
                const bf16_t* y0p = Y + (size_t)s0 * D + col0; const bf16_t* y1p = Y + (size_t)s1 * D + col0;
#pragma unroll
                for (int bj = 0; bj < 2; ++bj)
#pragma unroll
                    for (int n = 0; n < 2; ++n) { const int co = bj * HALF + n * 16;
                        const f32x4 xv = *(const f32x4*)(out + off + co); const u32x2 ya = *(const u32x2*)(y0p + co), yb = *(const u32x2*)(y1p + co), pp = *(const u32x2*)(PP + off + co);
                        const f32x4 a = acc[ai][bj][m][n] + bv[bj][n];
                        f32x4 o;
                        o[0] = ALPHA * xv[0] + w0 * bfl(ya.x) + w1 * bfl(yb.x) + sigm(a[0]) * bfl(pp.x);
                        o[1] = ALPHA * xv[1] + w0 * bfh(ya.x) + w1 * bfh(yb.x) + sigm(a[1]) * bfh(pp.x);
                        o[2] = ALPHA * xv[2] + w0 * bfl(ya.y) + w1 * bfl(yb.y) + sigm(a[2]) * bfl(pp.y);
                        o[3] = ALPHA * xv[3] + w0 * bfh(ya.y) + w1 * bfh(yb.y) + sigm(a[3]) * bfh(pp.y);
                        *(f32x4*)(out + off + co) = o; }
                asm volatile("" ::: "memory"); }
    }
};

template <class Epi, class Sched, bool ALIGN_EPI>
__device__ __forceinline__ void gemm_phase(PG8_LAS unsigned char* lds, const int K, const Sched& S, const Epi& E) {
    const int tid = threadIdx.x, wid = __builtin_amdgcn_readfirstlane(tid >> 6), lane = tid & 63, wr = wid >> 2, wc = wid & 3, fr = lane & 15, fq = lane >> 4;
    const int nt = K / BK;
    unsigned voffB[2]; int Rr[2], Cc[2];
#pragma unroll
    for (int i = 0; i < 2; ++i) { int R, C; stage_rc(tid * 16 + i * 8192, R, C); const int Rb = Epi::PERM ? ((R & ~31) + perm32(R & 31)) : R; Rr[i] = R; Cc[i] = C; voffB[i] = (unsigned)(Rb * K + C) * 2u; }
    const size_t kstep = (size_t)(BK * 2);
    const size_t hstep = (size_t)HALF * K * 2;
    const unsigned ldsw = (unsigned)wid * 1024u;
    const int aoff = lds_byte(wr * 64 + fr, fq * 8), boff = lds_byte(wc * 32 + fr, fq * 8);
#define PG8_SA(b, h) (((b) * 2 + (h)) * HTB)
#define PG8_SB(b, h) ((4 + (b) * 2 + (h)) * HTB)
#define PG8_STAGE(bufoff, gbase, voff) do { _Pragma("unroll") for (int _i = 0; _i < 2; ++_i) \
        __builtin_amdgcn_global_load_lds((const unsigned*)((const char*)(gbase) + (voff)[_i]), (PG8_LAS unsigned*)(lds + (bufoff) + ldsw + _i * 8192), 16, 0, 0); } while (0)
#define PG8_LDA(dst, b, h) do { _Pragma("unroll") for (int m = 0; m < 4; ++m) _Pragma("unroll") for (int k = 0; k < 2; ++k) dst[m][k] = *(const PG8_LAS bf16x8*)(lds + PG8_SA(b, h) + aoff + m * 2048 + k * 1024); } while (0)
#define PG8_LDB(dst, b, h) do { _Pragma("unroll") for (int n = 0; n < 2; ++n) _Pragma("unroll") for (int k = 0; k < 2; ++k) dst[n][k] = *(const PG8_LAS bf16x8*)(lds + PG8_SB(b, h) + boff + n * 2048 + k * 1024); } while (0)
#define PG8_MMA(ai, bj, At, Bt) do { __builtin_amdgcn_s_setprio(1); _Pragma("unroll") for (int m = 0; m < 4; ++m) _Pragma("unroll") for (int n = 0; n < 2; ++n) _Pragma("unroll") for (int k = 0; k < 2; ++k) \
        acc[ai][bj][m][n] = __builtin_amdgcn_mfma_f32_16x16x32_bf16(Bt[n][k], At[m][k], acc[ai][bj][m][n], 0, 0, 0); __builtin_amdgcn_s_setprio(0); } while (0)
#define PG8_WAIT_V(n) asm volatile("s_waitcnt vmcnt(" #n ")" ::: "memory")
#define PG8_WAIT_L(n) asm volatile("s_waitcnt lgkmcnt(" #n ")" ::: "memory")
#define PG8_BAR __builtin_amdgcn_s_barrier()
#define PG8_SCHED __builtin_amdgcn_sched_barrier(0)
    Unit cur, nxt; int ui = 0;
    if (!S.next(0, cur)) return;
    f32x4 acc[2][2][4][2];
#pragma unroll
    for (int a = 0; a < 2; ++a)
#pragma unroll
        for (int b = 0; b < 2; ++b)
#pragma unroll
            for (int m = 0; m < 4; ++m)
#pragma unroll
                for (int n = 0; n < 2; ++n) acc[a][b][m][n] = (f32x4){0.f, 0.f, 0.f, 0.f};
    bf16x8 At[4][2], B0[2][2], B1[2][2];
    unsigned vAc[2][2], vAn[2][2];
    S.a_off(cur, Rr, Cc, vAc);
    const char* cA = S.a_ptr(cur); const char* cB = S.b_ptr(cur);
    PG8_STAGE(PG8_SB(0, 0), cB, voffB); PG8_STAGE(PG8_SB(0, 1), cB + hstep, voffB); PG8_STAGE(PG8_SA(0, 0), cA, vAc[0]); PG8_STAGE(PG8_SA(0, 1), cA, vAc[1]);
    if (wr == 1) PG8_BAR;
    PG8_WAIT_V(2); PG8_BAR;
    PG8_STAGE(PG8_SB(1, 0), cB + kstep, voffB); PG8_STAGE(PG8_SA(1, 0), cA + kstep, vAc[0]); PG8_STAGE(PG8_SB(1, 1), cB + hstep + kstep, voffB);
    PG8_WAIT_V(6); PG8_BAR;
    for (;;) {
        const bool has_next = S.next(ui + 1, nxt);
        const char* nA = cA; const char* nB = cB;
#pragma unroll
        for (int h = 0; h < 2; ++h)
#pragma unroll
            for (int i = 0; i < 2; ++i) vAn[h][i] = vAc[h][i];
        if (has_next) { nA = S.a_ptr(nxt); nB = S.b_ptr(nxt); S.a_off(nxt, Rr, Cc, vAn); }
#pragma unroll 1
        for (int t = 0; t < nt; t += 2) {
            const bool last = (t == nt - 2);
            const char* a1 = cA + (size_t)(t + 1) * kstep;
            const char* a2 = last ? nA : cA + (size_t)(t + 2) * kstep; const char* b2 = last ? nB : cB + (size_t)(t + 2) * kstep;
            const char* a3 = a2 + kstep; const char* b3 = b2 + kstep;
            unsigned s0[2], s1[2];
#pragma unroll
            for (int i = 0; i < 2; ++i) { s0[i] = last ? vAn[0][i] : vAc[0][i]; s1[i] = last ? vAn[1][i] : vAc[1][i]; }
            PG8_LDB(B0, 0, 0); PG8_LDB(B1, 0, 1); PG8_SCHED; PG8_LDA(At, 0, 0); PG8_STAGE(PG8_SA(1, 1), a1, vAc[1]);
            PG8_WAIT_V(8); PG8_WAIT_L(0); PG8_BAR; PG8_MMA(0, 0, At, B0); PG8_MMA(0, 1, At, B1); PG8_BAR; PG8_SCHED;
            PG8_LDA(At, 0, 1); PG8_STAGE(PG8_SB(0, 0), b2, voffB); PG8_STAGE(PG8_SB(0, 1), b2 + hstep, voffB); PG8_STAGE(PG8_SA(0, 0), a2, s0);
            PG8_WAIT_V(8); PG8_WAIT_L(0); PG8_BAR; PG8_MMA(1, 0, At, B0); PG8_MMA(1, 1, At, B1); PG8_BAR; PG8_SCHED;
            PG8_LDB(B0, 1, 0); PG8_LDB(B1, 1, 1); PG8_SCHED; PG8_LDA(At, 1, 0); PG8_STAGE(PG8_SA(0, 1), a2, s1);
            PG8_WAIT_V(8); PG8_WAIT_L(0); PG8_BAR; PG8_MMA(0, 0, At, B0); PG8_MMA(0, 1, At, B1); PG8_BAR; PG8_SCHED;
            PG8_LDA(At, 1, 1); PG8_STAGE(PG8_SB(1, 0), b3, voffB); PG8_STAGE(PG8_SB(1, 1), b3 + hstep, voffB); PG8_STAGE(PG8_SA(1, 0), a3, s0);
            PG8_WAIT_V(8); PG8_WAIT_L(0); PG8_BAR; PG8_MMA(1, 0, At, B0); PG8_MMA(1, 1, At, B1); PG8_BAR; PG8_SCHED;
        }
        if constexpr (ALIGN_EPI) { if (wr == 0) PG8_BAR; }
        E(acc, cur, wr, wc, fr, fq);
        if (!has_next) break;
#pragma unroll
        for (int a = 0; a < 2; ++a)
#pragma unroll
            for (int b = 0; b < 2; ++b)
#pragma unroll
                for (int m = 0; m < 4; ++m)
#pragma unroll
                    for (int n = 0; n < 2; ++n) acc[a][b][m][n] = (f32x4){0.f, 0.f, 0.f, 0.f};
        cur = nxt; cA = nA; cB = nB; ++ui;
#pragma unroll
        for (int h = 0; h < 2; ++h)
#pragma unroll
            for (int i = 0; i < 2; ++i) vAc[h][i] = vAn[h][i];
        if constexpr (ALIGN_EPI) { if (wr == 1) PG8_BAR; }
    }
    PG8_WAIT_V(0);
    if constexpr (!ALIGN_EPI) { if (wr == 0) PG8_BAR; }
    PG8_BAR;
#undef PG8_SA
#undef PG8_SB
#undef PG8_STAGE
#undef PG8_LDA
#undef PG8_LDB
#undef PG8_MMA
#undef PG8_WAIT_V
#undef PG8_WAIT_L
#undef PG8_BAR
#undef PG8_SCHED
}
}

__device__ __forceinline__ unsigned pk2(float lo, float hi) { return (unsigned)f2bf(lo) | ((unsigned)f2bf(hi) << 16); }
typedef unsigned v4u __attribute__((ext_vector_type(4)));
__device__ __forceinline__ void transpose_item(const float* W, int K, int N, bf16* WT, int row_off, int row_mul, LAS float* scr, int item, int lane) {
    const int nblk = N / 32, kb = item / nblk, nb = item % nblk, k0 = 64 * kb, n0 = 32 * nb;
#pragma unroll 8
    for (int i = 0; i < 32; ++i) { const int kk = 2 * i + (lane >> 5); scr[kk * 33 + (lane & 31)] = W[(size_t)(k0 + kk) * N + n0 + (lane & 31)]; }
    asm volatile("s_waitcnt lgkmcnt(0)" ::: "memory");
    const int c = lane & 7;
#pragma unroll
    for (int j = 0; j < 4; ++j) { const int n = (lane >> 3) + 8 * j; const LAS float* s = scr + (8 * c) * 33 + n;
        v4u o; o.x = pk2(s[0 * 33], s[1 * 33]); o.y = pk2(s[2 * 33], s[3 * 33]); o.z = pk2(s[4 * 33], s[5 * 33]); o.w = pk2(s[6 * 33], s[7 * 33]);
        *(GAS v4u*)(WT + (size_t)(row_off + row_mul * (n0 + n)) * K + k0 + 8 * c) = o; }
    asm volatile("s_waitcnt lgkmcnt(0)" ::: "memory");
}

__device__ __forceinline__ void ph_lin(Frame& F) {
    const bf16* PR = (const bf16*)(F.ws + WS_PROJ); const float* mu = F.in[I_MU]; bf16* LIN = (bf16*)(F.ws + WS_LIN);
    for (int it = F.bid * NTHR + F.tid; it < T * 32; it += F.G * NTHR) {
        const int t = it >> 5, c8 = (it & 31) * 8;
        const pg8::u32x4 cur = *(const pg8::u32x4*)(PR + (size_t)t * DIN + 1536 + c8);
        pg8::u32x4 prv = (pg8::u32x4){0u, 0u, 0u, 0u};
        if (t % SEQ != 0) prv = *(const pg8::u32x4*)(PR + (size_t)(t - 1) * DIN + 1536 + c8);
        float o[8];
#pragma unroll
        for (int e = 0; e < 4; ++e) {
            const float c0 = pg8::bfl(cur[e]), c1 = pg8::bfh(cur[e]), p0 = pg8::bfl(prv[e]), p1 = pg8::bfh(prv[e]);
            o[2 * e] = c0 + (p0 - c0) * mu[1536 + c8 + 2 * e]; o[2 * e + 1] = c1 + (p1 - c1) * mu[1536 + c8 + 2 * e + 1];
        }
#pragma unroll
        for (int e = 0; e < 8; ++e) { if (c8 < 64) o[e] = tanhf(o[e]); else if (c8 >= 128) o[e] = sigmoidf_(o[e]); }
        pg8::u32x4 w; w.x = pg8::cvt_pk_bf16(o[0], o[1]); w.y = pg8::cvt_pk_bf16(o[2], o[3]); w.z = pg8::cvt_pk_bf16(o[4], o[5]); w.w = pg8::cvt_pk_bf16(o[6], o[7]);
        *(pg8::u32x4*)(LIN + (size_t)t * 256 + c8) = w;
    }
}
__device__ __forceinline__ void ph_wlora(Frame& F) {
    bf16* WL = (bf16*)(F.ws + WS_WLORA_T); const float* Wd = F.in[I_WDEC]; const float* Wa = F.in[I_WICLR]; const float* Wg = F.in[I_WGATE];
    for (int i = F.bid * NTHR + F.tid; i < 1536 * 256; i += F.G * NTHR) {
        const int n = i >> 8, k = i & 255; float v = 0.f;
        if (n < 512) { if (k < 64) v = Wd[k * DR + n]; }
        else if (n < 1024) { if (k >= 64 && k < 128) v = Wa[(k - 64) * DR + (n - 512)]; }
        else { if (k >= 128) v = Wg[(k - 128) * DR + (n - 1024)]; }
        WL[i] = f2bf(v);
    }
}

__device__ __forceinline__ void ph_wrouter(Frame& F) {
    bf16* WR = (bf16*)(F.ws + WS_WR_T); const float* Wgr = F.in[I_WGR]; const float* Wer = F.in[I_WER];
    for (int i = F.bid * NTHR + F.tid; i < 256 * D; i += F.G * NTHR) {
        const int n = i >> 10, k = i & 1023; const int o = n & 63; float v = 0.f;
        if (n < 128 && o < 36) { const float wv = o < 4 ? Wgr[k * 4 + o] : Wer[k * 32 + (o - 4)]; const float hi = bf2f(f2bf(wv)); v = (n < 64) ? hi : (wv - hi); }
        WR[i] = f2bf(v);
    }
}
__device__ __forceinline__ void ph_route2(Frame& F) {
    const float* LG = (const float*)(F.ws + WS_LOG); const float* bgr = F.in[I_BGR]; const float* ber = F.in[I_BER];
    int* tokE = (int*)(F.ws + WS_TOKE); float* tokW = (float*)(F.ws + WS_TOKW); int* tokP = (int*)(F.ws + WS_TOKP); int* slotTok = (int*)(F.ws + WS_SLOTTOK);
    unsigned* ecnt = F.ctl + CW_ECNT;
    for (int i = F.bid * NTHR + F.tid; i < NSLOT; i += F.G * NTHR) slotTok[i] = -1;
    for (int t = F.bid * NTHR + F.tid; t < T; t += F.G * NTHR) {
        const float* a = LG + (size_t)t * 128; const float* b = LG + (size_t)(T + t) * 128;
        float gl[4];
#pragma unroll
        for (int j = 0; j < 4; ++j) gl[j] = a[j] + a[64 + j] + b[j] + bgr[j];
        int gs = 0; float gm = gl[0];
#pragma unroll
        for (int j = 1; j < 4; ++j) if (gl[j] > gm) { gm = gl[j]; gs = j; }
        float se = 0.f;
#pragma unroll
        for (int j = 0; j < 4; ++j) se += __expf(gl[j] - gm);
        const float pg = 1.0f / se;
        float el[8];
#pragma unroll
        for (int j = 0; j < 8; ++j) { const int o = 4 + gs * 8 + j; el[j] = a[o] + a[64 + o] + b[o] + ber[gs * 8 + j]; }
        int i1 = 0; float v1 = el[0];
#pragma unroll
        for (int j = 1; j < 8; ++j) if (el[j] > v1) { v1 = el[j]; i1 = j; }
        int i2 = -1; float v2 = -3.0e38f;
#pragma unroll
        for (int j = 0; j < 8; ++j) if (j != i1 && el[j] > v2) { v2 = el[j]; i2 = j; }
        const float e2 = __expf(v2 - v1), w1 = pg / (1.0f + e2), w2 = pg * e2 / (1.0f + e2);
        const int ea = gs * 8 + i1, eb = gs * 8 + i2;
        tokE[2 * t] = ea; tokE[2 * t + 1] = eb; tokW[2 * t] = w1; tokW[2 * t + 1] = w2;
        tokP[2 * t] = (int)atomicAdd(&ecnt[ea], 1u); tokP[2 * t + 1] = (int)atomicAdd(&ecnt[eb], 1u);
    }
}
__device__ __forceinline__ void ph_wconv_small(Frame& F) {
    LAS float* scr = (LAS float*)(F.lds + F.wave * 16384);
    const int gw = F.bid * NWAVES + F.wave, NGW = F.G * NWAVES;
    constexpr int I_IN = (D / 64) * (DIN / 32), I_O = (D / 64) * (D / 32), I_PP = (DP / 64) * (D / 32);
    constexpr int NIT = I_IN + 2 * I_O + I_PP;
    for (int it = gw; it < NIT; it += NGW) {
        int r = it;
        if (r < I_IN) { transpose_item(F.in[I_WIN], D, DIN, (bf16*)(F.ws + WS_WIN_T), 0, 1, scr, r, F.lane); continue; } r -= I_IN;
        if (r < I_O) { transpose_item(F.in[I_WOUT], D, D, (bf16*)(F.ws + WS_WOUT_T), 0, 1, scr, r, F.lane); continue; } r -= I_O;
        if (r < I_O) { transpose_item(F.in[I_WPG], D, D, (bf16*)(F.ws + WS_WPG_T), 0, 1, scr, r, F.lane); continue; } r -= I_O;
        transpose_item(F.in[I_WPP], DP, D, (bf16*)(F.ws + WS_WPP_T), 0, 1, scr, r, F.lane);
    }
}
__device__ __forceinline__ void ph_wconv_exp(Frame& F) {
    LAS float* scr = (LAS float*)(F.lds + F.wave * 16384);
    const int gw = F.bid * NWAVES + F.wave, NGW = F.G * NWAVES;
    constexpr int I_G = (D / 64) * (DE / 32), I_D = (DE / 64) * (D / 32), PER_E = 2 * I_G + I_D;
    for (int it = gw; it < NE * PER_E; it += NGW) {
        const int e = it / PER_E; int r = it % PER_E;
        bf16* gu = (bf16*)(F.ws + WS_WGU_T) + (size_t)e * (2 * DE) * D; bf16* dn = (bf16*)(F.ws + WS_WD_T) + (size_t)e * D * DE;
        if (r < I_G) { transpose_item(F.in[I_WEG] + (size_t)e * D * DE, D, DE, gu, 0, 2, scr, r, F.lane); continue; } r -= I_G;
        if (r < I_G) { transpose_item(F.in[I_WEU] + (size_t)e * D * DE, D, DE, gu, 1, 2, scr, r, F.lane); continue; } r -= I_G;
        transpose_item(F.in[I_WED] + (size_t)e * DE * D, DE, D, dn, 0, 1, scr, r, F.lane);
    }
    const float4* p4 = (const float4*)F.in[I_P]; uint2* pb = (uint2*)(F.ws + WS_PB);
    for (size_t i = (size_t)F.bid * NTHR + F.tid; i < (size_t)T * DP / 4; i += (size_t)F.G * NTHR) { const float4 v = p4[i]; uint2 o; o.x = pk2(v.x, v.y); o.y = pk2(v.z, v.w); pb[i] = o; }
}
__device__ __forceinline__ void ph_proj_fast(Frame& F) {
    pg8::OrdStd S; S.init(F.ws + WS_XN, F.ws + WS_WIN_T, T, DIN, D, F.G, F.bid);
    pg8::EpiBf16 E{(bf16*)(F.ws + WS_PROJ), DIN, NSH / 256};
    pg8::gemm_phase<pg8::EpiBf16, pg8::OrdStd, true>(F.lds, D, S, E);
}
__device__ __forceinline__ void ph_lora_fast(Frame& F) {
    pg8::OrdStd S; S.init(F.ws + WS_LIN, F.ws + WS_WLORA_T, T, 1536, 256, F.G, F.bid);
    pg8::EpiLora E{(bf16*)(F.ws + WS_LW), F.in[I_W0], F.in[I_A0]};
    static_assert(WS_G - WS_ICLR == WS_ICLR - WS_LW, "LW, ICLR, G equally spaced");
    pg8::gemm_phase<pg8::EpiLora, pg8::OrdStd, true>(F.lds, 256, S, E);
}
__device__ __forceinline__ void ph_logits_fast(Frame& F) {
    pg8::OrdStd S; S.init(F.ws + WS_X1B, F.ws + WS_WR_T, 2 * T, 256, D, F.G, F.bid);
    pg8::EpiLog E{(float*)(F.ws + WS_LOG)};
    static_assert(WS_X1L == WS_X1B + (size_t)T * D * 2, "X1L follows X1B: one [2T][D] A operand");
    pg8::gemm_phase<pg8::EpiLog, pg8::OrdStd, true>(F.lds, D, S, E);
}
__device__ __forceinline__ void ph_wout_fast(Frame& F) {
    pg8::OrdStd S; S.init(F.ws + WS_CAT, F.ws + WS_WOUT_T, T, D, D, F.G, F.bid);
    pg8::EpiWout E{F.in[I_X], (const float*)(F.ws + WS_STAT0), F.in[I_LNEG], F.in[I_LNEB], F.out};
    pg8::gemm_phase<pg8::EpiWout, pg8::OrdStd, true>(F.lds, D, S, E);
}
__device__ __forceinline__ void ph_up_fast(Frame& F) {
    const int nt = (int)xb_ld(F.ctl + CW_NTILES);
    pg8::OrdExp<true> S{(const char*)(F.ws + WS_X1B), (const char*)(F.ws + WS_WGU_T), D, (const int*)(F.ws + WS_SLOTTOK), (const int*)(F.ws + WS_TILEE), nt, F.G, F.bid, (size_t)(2 * DE) * D * 2};
    pg8::EpiUp E{(bf16*)(F.ws + WS_HID)};
    pg8::gemm_phase<pg8::EpiUp, pg8::OrdExp<true>, true>(F.lds, D, S, E);
}
__device__ __forceinline__ void ph_down_fast(Frame& F) {
    const int nt = (int)xb_ld(F.ctl + CW_NTILES);
    pg8::OrdExp<false> S{(const char*)(F.ws + WS_HID), (const char*)(F.ws + WS_WD_T), DE, nullptr, (const int*)(F.ws + WS_TILEE), nt, F.G, F.bid, (size_t)D * DE * 2};
    pg8::EpiBf16 E{(bf16*)(F.ws + WS_Y), D, 1 << 30};
    pg8::gemm_phase<pg8::EpiBf16, pg8::OrdExp<false>, true>(F.lds, DE, S, E);
}
__device__ __forceinline__ void ph_pproj_fast(Frame& F) {
    pg8::OrdStd S; S.init(F.ws + WS_PB, F.ws + WS_WPP_T, T, D, DP, F.G, F.bid);
    pg8::EpiBf16 E{(bf16*)(F.ws + WS_PP), D, 1 << 30};
    pg8::gemm_phase<pg8::EpiBf16, pg8::OrdStd, true>(F.lds, DP, S, E);
}
__device__ __forceinline__ void ph_gate_fast(Frame& F) {
    pg8::OrdStd S; S.init(F.ws + WS_X1B, F.ws + WS_WPG_T, T, D, D, F.G, F.bid);
    pg8::EpiGate E{F.out, (const bf16*)(F.ws + WS_Y), (const bf16*)(F.ws + WS_PP), F.in[I_BPG], (const int*)(F.ws + WS_TOKP), (const float*)(F.ws + WS_TOKW)};
    pg8::gemm_phase<pg8::EpiGate, pg8::OrdStd, true>(F.lds, D, S, E);
}


namespace wk {
typedef short bf16x8 __attribute__((ext_vector_type(8)));
typedef float f32x4 __attribute__((ext_vector_type(4)));
typedef unsigned u32x2 __attribute__((ext_vector_type(2)));
typedef unsigned u32x4 __attribute__((ext_vector_type(4)));
constexpr int WST = 72;
constexpr int WBUF = 64 * WST * 2;
constexpr int NCHUNK = BATCH * NH * (SEQ / 64);
__device__ __forceinline__ LAS bf16* buf(LAS unsigned char* lds, int i) { return (LAS bf16*)(lds + i * WBUF); }
typedef __bf16 bf16v2 __attribute__((ext_vector_type(2)));
__device__ __forceinline__ unsigned pk(float lo, float hi) { bf16v2 v = {(__bf16)lo, (__bf16)hi}; return __builtin_bit_cast(unsigned, v); }
__device__ __forceinline__ f32x4 tile_mm(f32x4 acc, const LAS bf16* First, int f0, const LAS bf16* Second, int s0, int c, int q) {
    const LAS bf16* ap = First + (f0 + c) * WST + 8 * q; const LAS bf16* bp = Second + (s0 + c) * WST + 8 * q;
    const bf16x8 a0 = *(const LAS bf16x8*)ap, a1 = *(const LAS bf16x8*)(ap + 32), b0 = *(const LAS bf16x8*)bp, b1 = *(const LAS bf16x8*)(bp + 32);
    acc = __builtin_amdgcn_mfma_f32_16x16x32_bf16(a0, b0, acc, 0, 0, 0);
    acc = __builtin_amdgcn_mfma_f32_16x16x32_bf16(a1, b1, acc, 0, 0, 0);
    return acc;
}
__device__ __forceinline__ void write_rm(LAS bf16* dst, int m0, int n0, f32x4 acc, int c, int q) {
#pragma unroll
    for (int r = 0; r < 4; ++r) dst[(m0 + 4 * q + r) * WST + n0 + c] = f2bf(acc[r]);
}
__device__ __forceinline__ void write_tr(LAS bf16* dst, int m0, int n0, f32x4 acc, int c, int q) {
    u32x2 w; w.x = pk(acc[0], acc[1]); w.y = pk(acc[2], acc[3]);
    *(LAS u32x2*)(dst + (n0 + c) * WST + m0 + 4 * q) = w;
}
__device__ __forceinline__ f32x4 read_tr(const LAS bf16* XT, int m0, int n0, int c, int q) {
    const u32x2 w = *(const LAS u32x2*)(XT + (n0 + c) * WST + m0 + 4 * q);
    return (f32x4){pg8::bfl(w.x), pg8::bfh(w.x), pg8::bfl(w.y), pg8::bfh(w.y)};
}
__device__ __forceinline__ f32x4 read_rm4(const LAS bf16* X, int m0, int n0, int c, int q) {
    const u32x2 w = *(const LAS u32x2*)(X + (m0 + c) * WST + n0 + 4 * q);
    return (f32x4){pg8::bfl(w.x), pg8::bfh(w.x), pg8::bfl(w.y), pg8::bfh(w.y)};
}
__device__ __forceinline__ void store4(bf16* g, f32x4 v) { u32x2 w; w.x = pk(v[0], v[1]); w.y = pk(v[2], v[3]); *(u32x2*)g = w; }
}

__device__ __forceinline__ void ph_wkv1(Frame& F) {
    using namespace wk;
    const bf16* PR = (const bf16*)(F.ws + WS_PROJ); const bf16* iIC = (const bf16*)(F.ws + WS_ICLR); const float* mu = F.in[I_MU]; const float* k_k = F.in[I_KK]; const float* k_a = F.in[I_KA];
    const bf16* iLW = (const bf16*)(F.ws + WS_LW); const float* r_k = F.in[I_RK];
    bf16* oM = (bf16*)(F.ws + WS_CM); bf16* oN = (bf16*)(F.ws + WS_CN); bf16* oP = (bf16*)(F.ws + WS_CP); bf16* oY = (bf16*)(F.ws + WS_CY); float* oC = (float*)(F.ws + WS_CC);
    LAS unsigned char* L = F.lds; LAS float* scr = (LAS float*)(L + 14 * WBUF);
    const int lane = F.lane, w = F.wave, c = lane & 15, q = lane >> 4;
    for (int cid = F.bid; cid < NCHUNK; cid += F.G) {
        const int seq = cid >> 6, cc = cid & 63, b = seq >> 3, h = seq & 7; const int t0 = b * SEQ + cc * 64;
        const int j = lane, tq = w; const int ch = h * 64 + j;
        const size_t g0 = (size_t)(t0 + 8 * tq) * DR + ch;
        const bf16* pr0 = PR + (size_t)(t0 + 8 * tq) * DIN + ch;
        float lw[8], cs[8]; float s = 0.f;
#pragma unroll
        for (int e = 0; e < 8; ++e) { lw[e] = bf2f(iLW[g0 + (size_t)e * DR]); s += lw[e]; cs[e] = s; }
        scr[tq * 64 + j] = s;
        const bool first = (cc == 0 && tq == 0);
        float pr = first ? 0.f : bf2f(pr0[-(long)DIN]), pkx = first ? 0.f : bf2f(pr0[-(long)DIN + 512]), pv = first ? 0.f : bf2f(pr0[-(long)DIN + 1024]);
        const float mur = mu[ch], muk = mu[512 + ch], muv = mu[1024 + ch], kkc = k_k[ch], kac = k_a[ch];
        __syncthreads();
        float pre = 0.f, tot = 0.f;
#pragma unroll
        for (int qq = 0; qq < 8; ++qq) { const float x = scr[qq * 64 + j]; tot += x; pre += (qq < tq) ? x : 0.f; }
        const float rkj = r_k[ch];
        unsigned vT[4], aT[4], bhT[4], khT[4]; float prv = 0.f, pra = 0.f, prb = 0.f, prk = 0.f;
#pragma unroll
        for (int e = 0; e < 8; ++e) {
            const int t = 8 * tq + e; const float cse = cs[e] + pre;
            const float e1 = __expf(cse), ei = __expf(-cse), ep = __expf(cse - lw[e]), eh = __expf(tot - cse);
            const bf16* prow = pr0 + (size_t)e * DIN;
            const float cr = bf2f(prow[0]), ck = bf2f(prow[512]), cv = bf2f(prow[1024]);
            const float rr = cr + (pr - cr) * mur, kraw = ck + (pkx - ck) * muk, vv = cv + (pv - cv) * muv; pr = cr; pkx = ck; pv = cv;
            const float ic = bf2f(iIC[g0 + (size_t)e * DR]);
            float kkv = kraw * kkc; const float nrm = sqrtf(wave_sum(kkv * kkv)); kkv = kkv / fmaxf(nrm, 1e-12f);
            const float kv = kraw * (1.0f + (ic - 1.0f) * kac), kbv = kkv * ic;
            const float at = -kkv * ep, rt = rr * e1, bt = kbv * ei, kt = kv * ei, bh = kbv * eh, kh = kv * eh;
            buf(L, 0)[t * WST + j] = f2bf(at); buf(L, 1)[t * WST + j] = f2bf(rt); buf(L, 2)[t * WST + j] = f2bf(bt); buf(L, 3)[t * WST + j] = f2bf(kt);
            if (e & 1) { vT[e >> 1] = pk(prv, vv); aT[e >> 1] = pk(pra, at); bhT[e >> 1] = pk(prb, bh); khT[e >> 1] = pk(prk, kh); }
            else { prv = vv; pra = at; prb = bh; prk = kh; }
            const float bon = wave_sum(rr * kv * rkj);
            if (lane == 0) oC[(size_t)(t0 + t) * NH + h] = bon;
        }
        *(LAS u32x4*)(buf(L, 4) + j * WST + 8 * tq) = (u32x4){vT[0], vT[1], vT[2], vT[3]};
        *(LAS u32x4*)(buf(L, 5) + j * WST + 8 * tq) = (u32x4){aT[0], aT[1], aT[2], aT[3]};
        *(LAS u32x4*)(buf(L, 6) + j * WST + 8 * tq) = (u32x4){bhT[0], bhT[1], bhT[2], bhT[3]};
        *(LAS u32x4*)(buf(L, 7) + j * WST + 8 * tq) = (u32x4){khT[0], khT[1], khT[2], khT[3]};
        __syncthreads();
        if (w == 0) scr[j] = __expf(tot);
#pragma unroll 1
        for (int it = 0; it < 8; ++it) {
            const int tile = w * 8 + it, prod = tile >> 4, tm = (tile >> 2) & 3, tn = tile & 3;
            const LAS bf16* A = buf(L, (prod >> 1) ? 1 : 0); const LAS bf16* B = buf(L, (prod & 1) ? 3 : 2);
            f32x4 acc = (f32x4){0.f, 0.f, 0.f, 0.f};
            if (tn <= tm) acc = tile_mm(acc, A, 16 * tm, B, 16 * tn, c, q);
#pragma unroll
            for (int r = 0; r < 4; ++r) { const int m = 16 * tm + 4 * q + r, n = 16 * tn + c; const bool keep = (prod < 2) ? (n < m) : (n <= m); acc[r] = keep ? acc[r] : 0.f; }
            write_rm(buf(L, prod == 0 ? 8 : 9 + prod), 16 * tm, 16 * tn, acc, c, q);
            if (prod == 0) { write_tr(buf(L, 9), 16 * tm, 16 * tn, acc, c, q); f32x4 t1 = acc;
#pragma unroll
                for (int r = 0; r < 4; ++r) t1[r] += (16 * tm + 4 * q + r == 16 * tn + c) ? 1.0f : 0.f;
                write_tr(buf(L, 13), 16 * tm, 16 * tn, t1, c, q); }
        }
        __syncthreads();
#define WK_SQ(sq_rm, sq_tr, d_rm, d_tr, tile) do { const int tm = ((tile) >> 2) & 3, tn = (tile) & 3; f32x4 acc = (f32x4){0.f, 0.f, 0.f, 0.f}; \
            acc = tile_mm(acc, buf(L, sq_rm), 16 * tm, buf(L, sq_tr), 16 * tn, c, q); write_rm(buf(L, d_rm), 16 * tm, 16 * tn, acc, c, q); if ((d_tr) >= 0) write_tr(buf(L, (d_tr) < 0 ? 0 : (d_tr)), 16 * tm, 16 * tn, acc, c, q); } while (0)
#define WK_TU(p_rm, told_tr, d, final_rm, tile) do { const int tm = ((tile) >> 2) & 3, tn = (tile) & 3; f32x4 acc = read_tr(buf(L, told_tr), 16 * tm, 16 * tn, c, q); \
            acc = tile_mm(acc, buf(L, p_rm), 16 * tm, buf(L, told_tr), 16 * tn, c, q); if (final_rm) write_rm(buf(L, d), 16 * tm, 16 * tn, acc, c, q); else write_tr(buf(L, d), 16 * tm, 16 * tn, acc, c, q); } while (0)
#pragma unroll 1
        for (int it = 0; it < 4; ++it) { const int tile = w * 4 + it;
            if (tile < 16) WK_SQ(8, 9, 0, 2, tile);
            else { const int tm = (tile >> 2) & 3, tn = tile & 3; f32x4 acc = (f32x4){0.f, 0.f, 0.f, 0.f}; acc = tile_mm(acc, buf(L, 10), 16 * tm, buf(L, 4), 16 * tn, c, q); write_tr(buf(L, 3), 16 * tm, 16 * tn, acc, c, q); } }
        __syncthreads();
#pragma unroll 1
        for (int it = 0; it < 4; ++it) { const int tile = w * 4 + it; if (tile < 16) WK_SQ(0, 2, 8, 9, tile); else WK_TU(0, 13, 10, false, tile); }
        __syncthreads();
#pragma unroll 1
        for (int it = 0; it < 4; ++it) { const int tile = w * 4 + it; if (tile < 16) WK_SQ(8, 9, 0, 2, tile); else WK_TU(8, 10, 13, false, tile); }
        __syncthreads();
#pragma unroll 1
        for (int it = 0; it < 4; ++it) { const int tile = w * 4 + it; if (tile < 16) WK_SQ(0, 2, 8, 9, tile); else WK_TU(0, 13, 10, false, tile); }
        __syncthreads();
#pragma unroll 1
        for (int it = 0; it < 4; ++it) { const int tile = w * 4 + it; if (tile < 16) WK_SQ(8, 9, 0, -1, tile); else WK_TU(8, 10, 13, false, tile); }
        __syncthreads();
#pragma unroll 1
        for (int it = 0; it < 2; ++it) { const int tile = w * 2 + it; WK_TU(0, 13, 2, true, tile); }
        __syncthreads();
#pragma unroll 1
        for (int it = 0; it < 4; ++it) { const int tile = w * 4 + it, tm = (tile >> 2) & 3, tn = tile & 3; f32x4 acc = (f32x4){0.f, 0.f, 0.f, 0.f};
            acc = tile_mm(acc, buf(L, 2), 16 * tm, buf(L, tile < 16 ? 3 : 5), 16 * tn, c, q); write_tr(buf(L, tile < 16 ? 8 : 9), 16 * tm, 16 * tn, acc, c, q); }
        __syncthreads();
        bf16* gP = oP + (size_t)cid * 4096; bf16* gY = oY + (size_t)cid * 4096; bf16* gM = oM + (size_t)cid * 4096; bf16* gN = oN + (size_t)cid * 4096;
#pragma unroll 1
        for (int it = 0; it < 8; ++it) {
            const int tile = w * 8 + it, prod = tile >> 4, tm = (tile >> 2) & 3, tn = tile & 3;
            if (prod == 0) {
                f32x4 acc = read_rm4(buf(L, 1), 16 * tm, 16 * tn, c, q);
                acc = tile_mm(acc, buf(L, 9), 16 * tn, buf(L, 11), 16 * tm, c, q);
                store4(gP + (16 * tm + c) * 64 + 16 * tn + 4 * q, acc);
            } else if (prod == 1) {
                f32x4 acc = (f32x4){0.f, 0.f, 0.f, 0.f};
                acc = tile_mm(acc, buf(L, 8), 16 * tn, buf(L, 11), 16 * tm, c, q);
                acc = tile_mm(acc, buf(L, 4), 16 * tn, buf(L, 12), 16 * tm, c, q);
                store4(gY + (16 * tm + c) * 64 + 16 * tn + 4 * q, acc);
            } else if (prod == 2) {
                f32x4 acc = (f32x4){0.f, 0.f, 0.f, 0.f};
                acc = tile_mm(acc, buf(L, 9), 16 * tn, buf(L, 6), 16 * tm, c, q);
#pragma unroll
                for (int r = 0; r < 4; ++r) acc[r] += (16 * tm + c == 16 * tn + 4 * q + r) ? scr[16 * tm + c] : 0.f;
                store4(gM + (16 * tm + c) * 64 + 16 * tn + 4 * q, acc);
            } else {
                f32x4 acc = (f32x4){0.f, 0.f, 0.f, 0.f};
                acc = tile_mm(acc, buf(L, 6), 16 * tm, buf(L, 8), 16 * tn, c, q);
                acc = tile_mm(acc, buf(L, 7), 16 * tm, buf(L, 4), 16 * tn, c, q);
                store4(gN + (16 * tn + c) * 64 + 16 * tm + 4 * q, acc);
            }
        }
        __syncthreads();
#undef WK_SQ
#undef WK_TU
    }
}

__device__ __forceinline__ void ph_gmlp_fast(Frame& F) {
    using namespace wk;
    constexpr int GST = 136;
    const bf16* PR = (const bf16*)(F.ws + WS_PROJ); const float* lg = F.in[I_GLNG]; const float* lb = F.in[I_GLNB]; const float* wsp = F.in[I_WSP]; const float* bsp = F.in[I_BSP];
    bf16* CAT = (bf16*)(F.ws + WS_CAT);
    LAS bf16* ZT = (LAS bf16*)F.lds; LAS bf16* WL = (LAS bf16*)(F.lds + 128 * GST * 2);
    const int lane = F.lane, w = F.wave, c = lane & 15, q = lane >> 4;
    for (int item = F.bid; item < BATCH * (SEQ / CH) * GG; item += F.G) {
        const int g = item & 3, chunk = item >> 2; const int t0 = chunk * CH;
        const int d0 = 8 * c;
        float gv[8], bv[8];
#pragma unroll
        for (int e = 0; e < 8; ++e) { gv[e] = lg[g * GW + d0 + e]; bv[e] = lb[g * GW + d0 + e]; }
#pragma unroll
        for (int i = 0; i < 4; ++i) {
            const int s = 16 * w + 4 * i + q;
            const u32x4 raw = *(const u32x4*)(PR + (size_t)(t0 + s) * DIN + NSH + DG + g * GW + d0);
            float v[8]; float sum = 0.f;
#pragma unroll
            for (int e = 0; e < 4; ++e) { v[2 * e] = pg8::bfl(raw[e]); v[2 * e + 1] = pg8::bfh(raw[e]); sum += v[2 * e] + v[2 * e + 1]; }
            sum += __shfl_xor(sum, 1); sum += __shfl_xor(sum, 2); sum += __shfl_xor(sum, 4); sum += __shfl_xor(sum, 8);
            const float mean = sum * (1.f / GW); float sq = 0.f;
#pragma unroll
            for (int e = 0; e < 8; ++e) { v[e] -= mean; sq += v[e] * v[e]; }
            sq += __shfl_xor(sq, 1); sq += __shfl_xor(sq, 2); sq += __shfl_xor(sq, 4); sq += __shfl_xor(sq, 8);
            const float rstd = 1.0f / sqrtf(sq * (1.f / GW) + LN_EPS);
#pragma unroll
            for (int e = 0; e < 8; ++e) ZT[(d0 + e) * GST + s] = f2bf(v[e] * rstd * gv[e] + bv[e]);
        }
        { const int t = F.tid >> 2, s0 = (F.tid & 3) * 32; const float* wrow = wsp + ((size_t)g * CH + t) * CH + s0;
#pragma unroll
          for (int i = 0; i < 4; ++i) { const float4 a = *(const float4*)(wrow + 8 * i), b = *(const float4*)(wrow + 8 * i + 4); const int sb = s0 + 8 * i;
              u32x4 o; o.x = pk(sb + 0 <= t ? a.x : 0.f, sb + 1 <= t ? a.y : 0.f); o.y = pk(sb + 2 <= t ? a.z : 0.f, sb + 3 <= t ? a.w : 0.f);
              o.z = pk(sb + 4 <= t ? b.x : 0.f, sb + 5 <= t ? b.y : 0.f); o.w = pk(sb + 6 <= t ? b.z : 0.f, sb + 7 <= t ? b.w : 0.f);
              *(LAS u32x4*)(WL + t * GST + sb) = o; } }
        __syncthreads();
#pragma unroll 1
        for (int half = 0; half < 2; ++half) {
            const int tm = half == 0 ? w : 7 - w; const int nks = (16 * tm + 15) / 32 + 1;
#pragma unroll 1
            for (int tn = 0; tn < 8; ++tn) {
                f32x4 acc = (f32x4){0.f, 0.f, 0.f, 0.f};
                const LAS bf16* ap = ZT + (16 * tn + c) * GST + 8 * q; const LAS bf16* bp = WL + (16 * tm + c) * GST + 8 * q;
                for (int ks = 0; ks < nks; ++ks) { const bf16x8 a = *(const LAS bf16x8*)(ap + 32 * ks), b = *(const LAS bf16x8*)(bp + 32 * ks); acc = __builtin_amdgcn_mfma_f32_16x16x32_bf16(a, b, acc, 0, 0, 0); }
                const int t = 16 * tm + c; const float bias = bsp[g * CH + t];
                const size_t tg = (size_t)(t0 + t);
                const u32x2 zu = *(const u32x2*)(PR + tg * DIN + NSH + g * GW + 16 * tn + 4 * q);
                f32x4 r; r[0] = pg8::bfl(zu.x) * (acc[0] + bias); r[1] = pg8::bfh(zu.x) * (acc[1] + bias); r[2] = pg8::bfl(zu.y) * (acc[2] + bias); r[3] = pg8::bfh(zu.y) * (acc[3] + bias);
                store4(CAT + tg * D + DR + g * GW + 16 * tn + 4 * q, r);
            }
        }
        __syncthreads();
    }
}
__device__ __forceinline__ void ph_wkv2(Frame& F) {
    using namespace wk;
    if (F.wave != 0) return;
    const bf16* gM = (const bf16*)(F.ws + WS_CM); const bf16* gN = (const bf16*)(F.ws + WS_CN); bf16* gH = (bf16*)(F.ws + WS_CH);
    const int c = F.lane & 15, q = F.lane >> 4;
    for (int task = F.bid; task < 128; task += F.G) {
        const int seq = task >> 2, i0 = (task & 3) * 16;
        f32x4 H[4];
#pragma unroll
        for (int t = 0; t < 4; ++t) H[t] = (f32x4){0.f, 0.f, 0.f, 0.f};
        u32x2 mA[4][2][2], nA[4], mB[4][2][2], nB[4];
#define WK_LOAD(mX, nX, cid) do { const bf16* pm = gM + (size_t)(cid) * 4096; const bf16* pn = gN + (size_t)(cid) * 4096; \
            _Pragma("unroll") for (int to = 0; to < 4; ++to) { nX[to] = *(const u32x2*)(pn + (i0 + c) * 64 + 16 * to + 4 * q); \
            _Pragma("unroll") for (int ks = 0; ks < 2; ++ks) { mX[to][ks][0] = *(const u32x2*)(pm + (16 * to + c) * 64 + 32 * ks + 4 * q); mX[to][ks][1] = *(const u32x2*)(pm + (16 * to + c) * 64 + 32 * ks + 16 + 4 * q); } } } while (0)
#define WK_STEP(mX, nX, cid) do { bf16* ph = gH + (size_t)(cid) * 4096; \
            _Pragma("unroll") for (int to = 0; to < 4; ++to) store4(ph + (i0 + c) * 64 + 16 * to + 4 * q, H[to]); \
            bf16x8 hh[2], hl[2]; \
            _Pragma("unroll") for (int ks = 0; ks < 2; ++ks) { unsigned wh[4], wl[4]; \
                _Pragma("unroll") for (int hf = 0; hf < 2; ++hf) { const f32x4 x = H[2 * ks + hf]; const unsigned p0 = pk(x[0], x[1]), p1 = pk(x[2], x[3]); wh[2 * hf] = p0; wh[2 * hf + 1] = p1; \
                    wl[2 * hf] = pk(x[0] - pg8::bfl(p0), x[1] - pg8::bfh(p0)); wl[2 * hf + 1] = pk(x[2] - pg8::bfl(p1), x[3] - pg8::bfh(p1)); } \
                hh[ks] = __builtin_bit_cast(bf16x8, (u32x4){wh[0], wh[1], wh[2], wh[3]}); hl[ks] = __builtin_bit_cast(bf16x8, (u32x4){wl[0], wl[1], wl[2], wl[3]}); } \
            _Pragma("unroll") for (int to = 0; to < 4; ++to) { f32x4 acc = (f32x4){pg8::bfl(nX[to].x), pg8::bfh(nX[to].x), pg8::bfl(nX[to].y), pg8::bfh(nX[to].y)}; \
                _Pragma("unroll") for (int ks = 0; ks < 2; ++ks) { const bf16x8 mf = __builtin_bit_cast(bf16x8, (u32x4){mX[to][ks][0].x, mX[to][ks][0].y, mX[to][ks][1].x, mX[to][ks][1].y}); \
                    acc = __builtin_amdgcn_mfma_f32_16x16x32_bf16(mf, hh[ks], acc, 0, 0, 0); acc = __builtin_amdgcn_mfma_f32_16x16x32_bf16(mf, hl[ks], acc, 0, 0, 0); } \
                Hn[to] = acc; } \
            _Pragma("unroll") for (int to = 0; to < 4; ++to) H[to] = Hn[to]; } while (0)
        f32x4 Hn[4];
        const int cid0 = seq * 64;
        WK_LOAD(mA, nA, cid0);
#pragma unroll 1
        for (int cc = 0; cc < 64; cc += 2) {
            WK_LOAD(mB, nB, cid0 + cc + 1);
            WK_STEP(mA, nA, cid0 + cc);
            if (cc + 2 < 64) WK_LOAD(mA, nA, cid0 + cc + 2);
            WK_STEP(mB, nB, cid0 + cc + 1);
        }
#undef WK_LOAD
#undef WK_STEP
    }
}
__device__ __forceinline__ void ph_wkv3(Frame& F) {
    using namespace wk;
    const bf16* gP = (const bf16*)(F.ws + WS_CP); const bf16* gY = (const bf16*)(F.ws + WS_CY); const bf16* gH = (const bf16*)(F.ws + WS_CH); const float* gC = (const float*)(F.ws + WS_CC);
    const bf16* PR = (const bf16*)(F.ws + WS_PROJ); const float* mu = F.in[I_MU]; const bf16* iG = (const bf16*)(F.ws + WS_G); const float* gng = F.in[I_GNG]; const float* gnb = F.in[I_GNB];
    bf16* CAT = (bf16*)(F.ws + WS_CAT);
    const int c = F.lane & 15, q = F.lane >> 4;
    const int gw = F.bid * NWAVES + F.wave, NGW = F.G * NWAVES;
    for (int cid = gw; cid < NCHUNK; cid += NGW) {
        const int seq = cid >> 6, cc = cid & 63, b = seq >> 3, h = seq & 7; const int t0 = b * SEQ + cc * 64;
        const bf16* pp = gP + (size_t)cid * 4096; const bf16* ph = gH + (size_t)cid * 4096; const bf16* py = gY + (size_t)cid * 4096;
        bf16x8 hf[4][2];
#pragma unroll
        for (int ti = 0; ti < 4; ++ti)
#pragma unroll
            for (int ks = 0; ks < 2; ++ks) hf[ti][ks] = *(const bf16x8*)(ph + (16 * ti + c) * 64 + 32 * ks + 8 * q);
        f32x4 gg[4], gb[4], mv[4];
#pragma unroll
        for (int ti = 0; ti < 4; ++ti) { gg[ti] = *(const f32x4*)(gng + h * 64 + 16 * ti + 4 * q); gb[ti] = *(const f32x4*)(gnb + h * 64 + 16 * ti + 4 * q); mv[ti] = *(const f32x4*)(mu + 1024 + h * 64 + 16 * ti + 4 * q); }
#pragma unroll 1
        for (int tt = 0; tt < 4; ++tt) {
            const bf16x8 p0 = *(const bf16x8*)(pp + (16 * tt + c) * 64 + 8 * q), p1 = *(const bf16x8*)(pp + (16 * tt + c) * 64 + 32 + 8 * q);
            f32x4 y[4]; float s = 0.f;
#pragma unroll
            for (int ti = 0; ti < 4; ++ti) { const u32x2 y0 = *(const u32x2*)(py + (16 * tt + c) * 64 + 16 * ti + 4 * q);
                f32x4 acc = (f32x4){pg8::bfl(y0.x), pg8::bfh(y0.x), pg8::bfl(y0.y), pg8::bfh(y0.y)};
                acc = __builtin_amdgcn_mfma_f32_16x16x32_bf16(hf[ti][0], p0, acc, 0, 0, 0); acc = __builtin_amdgcn_mfma_f32_16x16x32_bf16(hf[ti][1], p1, acc, 0, 0, 0);
                y[ti] = acc; s += (acc[0] + acc[1]) + (acc[2] + acc[3]); }
            s += __shfl_xor(s, 16); s += __shfl_xor(s, 32);
            const float mean = s * (1.f / 64.f); float v2 = 0.f;
#pragma unroll
            for (int ti = 0; ti < 4; ++ti) { y[ti] = y[ti] - mean; v2 += (y[ti][0] * y[ti][0] + y[ti][1] * y[ti][1]) + (y[ti][2] * y[ti][2] + y[ti][3] * y[ti][3]); }
            v2 += __shfl_xor(v2, 16); v2 += __shfl_xor(v2, 32);
            const float rstd = 1.0f / sqrtf(v2 * (1.f / 64.f) + GN_EPS);
            const int tg = t0 + 16 * tt + c; const float bon = gC[(size_t)tg * NH + h];
#pragma unroll
            for (int ti = 0; ti < 4; ++ti) { const size_t o = (size_t)tg * DR + h * 64 + 16 * ti + 4 * q; const bf16* pv = PR + (size_t)tg * DIN + 1024 + h * 64 + 16 * ti + 4 * q;
                const u32x2 vc = *(const u32x2*)pv, gv = *(const u32x2*)(iG + o); u32x2 vp = (u32x2){0u, 0u}; if (tg % SEQ != 0) vp = *(const u32x2*)(pv - DIN);
                f32x4 vv; { const float c0 = pg8::bfl(vc.x), c1 = pg8::bfh(vc.x), c2 = pg8::bfl(vc.y), c3 = pg8::bfh(vc.y);
                    vv[0] = c0 + (pg8::bfl(vp.x) - c0) * mv[ti][0]; vv[1] = c1 + (pg8::bfh(vp.x) - c1) * mv[ti][1]; vv[2] = c2 + (pg8::bfl(vp.y) - c2) * mv[ti][2]; vv[3] = c3 + (pg8::bfh(vp.y) - c3) * mv[ti][3]; }
                f32x4 r;
                r[0] = (y[ti][0] * rstd * gg[ti][0] + gb[ti][0] + bon * vv[0]) * pg8::bfl(gv.x);
                r[1] = (y[ti][1] * rstd * gg[ti][1] + gb[ti][1] + bon * vv[1]) * pg8::bfh(gv.x);
                r[2] = (y[ti][2] * rstd * gg[ti][2] + gb[ti][2] + bon * vv[2]) * pg8::bfl(gv.y);
                r[3] = (y[ti][3] * rstd * gg[ti][3] + gb[ti][3] + bon * vv[3]) * pg8::bfh(gv.y);
                store4(CAT + (size_t)tg * D + h * 64 + 16 * ti + 4 * q, r); }
        }
    }
}

constexpr int NPHASE = 18;
struct Args { const float* in[35]; float* out; unsigned char* ws; int ph_lo, ph_hi; };
__global__ void __launch_bounds__(NTHR, 2) mk_fwd(Args args) {
    extern __shared__ __attribute__((aligned(16))) unsigned char lds[];
    Frame F;
    F.lds = (LAS unsigned char*)lds; F.sm = (float*)lds;
    F.tid = threadIdx.x; F.lane = F.tid & 63; F.wave = __builtin_amdgcn_readfirstlane(F.tid >> 6); F.G = gridDim.x; F.bid = blockIdx.x;
    F.ws = args.ws; F.out = args.out; F.ctl = (unsigned*)(args.ws + WS_CTL);
#pragma unroll
    for (int i = 0; i < 35; ++i) F.in[i] = args.in[i];
    volatile LAS unsigned* MISC = (volatile LAS unsigned*)(F.lds + MISC_OFF);
    for (int u = F.tid; u < (LDS_BYTES - LDSCTL_OFF) / 4; u += NTHR) ((LAS unsigned*)(F.lds + LDSCTL_OFF))[u] = 0u;
    __syncthreads();
    XcdBarrier bar; bar.bar = F.ctl + CW_BAR; bar.x = 0; bar.st = nullptr;
    if (!MK_PER_PHASE) bar = xcd_barrier_post(F.ctl + CW_BAR, MISC + 8);
    const int lo = args.ph_lo, hi = args.ph_hi;
#define IN(k) (lo <= (k) && (k) < hi)
#define SEAM(k) do { if (IN(k) && IN((k) + 1)) xcd_barrier(bar); } while (0)
    if (IN(0)) { ph_wconv_small(F); ph_wlora(F); ph_wrouter(F); ph_ln0(F); }
    SEAM(0);
    if (IN(1)) ph_proj_fast(F);
    SEAM(1);
    if (IN(2)) { ph_lin(F); ph_gmlp_fast(F); }
    SEAM(2);
    if (IN(3)) ph_lora_fast(F);
    SEAM(3);
    if (IN(4)) ph_wkv1(F);
    SEAM(4);
    if (IN(5)) ph_wkv2(F);
    SEAM(5);
    if (IN(6)) ph_wkv3(F);
    SEAM(6);
    if (IN(7)) ph_wout_fast(F);
    SEAM(7);
    if (IN(8)) ph_rowln(F, F.in[I_LN1G], F.in[I_LN1B], (bf16*)(F.ws + WS_X1B), (bf16*)(F.ws + WS_X1L));
    SEAM(8);
    if (IN(9)) ph_logits_fast(F);
    SEAM(9);
    if (IN(10)) { ph_route2(F); ph_wconv_exp(F); }
    SEAM(10);
    if (IN(11)) ph_bucket(F);
    SEAM(11);
    if (IN(12)) ph_up_fast(F);
    SEAM(12);
    if (IN(13)) ph_down_fast(F);
    SEAM(13);
    if (IN(14)) ph_pproj_fast(F);
    SEAM(14);
    if (IN(15)) ph_gate_fast(F);
    SEAM(15);
    if (IN(16)) ph_rowln(F, F.in[I_LN2G], F.in[I_LN2B], nullptr, nullptr);
#undef IN
#undef SEAM
}

extern "C" void kernel_launch(void* const* d_in, const int* in_sizes, int n_in, void* d_out, int out_size, void* d_ws, size_t ws_size, hipStream_t stream) {
    static int grid = 0;
    if (grid == 0) {
        if (n_in != 35 || out_size != T * D || ws_size < WS_END) { fprintf(stderr, "kernel_launch: unexpected shapes n_in %d out %d ws %zu (need %zu)\n", n_in, out_size, ws_size, (size_t)WS_END); grid = -1; return; }
        int dev = 0, cus = 0, per_cu = 0;
        if (hipGetDevice(&dev) != hipSuccess || hipDeviceGetAttribute(&cus, hipDeviceAttributeMultiprocessorCount, dev) != hipSuccess) { grid = -1; return; }
        if (hipFuncSetAttribute((const void*)mk_fwd, hipFuncAttributeMaxDynamicSharedMemorySize, LDS_BYTES) != hipSuccess) { fprintf(stderr, "kernel_launch: hipFuncSetAttribute failed\n"); grid = -1; return; }
        if (hipOccupancyMaxActiveBlocksPerMultiprocessor(&per_cu, (const void*)mk_fwd, NTHR, LDS_BYTES) != hipSuccess || per_cu < 1) fprintf(stderr, "kernel_launch: occupancy query says %d\n", per_cu);
        (void)hipGetLastError();
        grid = cus;
    }
    if (grid < 0) return;
    if (hipMemsetAsync((char*)d_ws + WS_CTL, 0, CTL_ZERO_BYTES, stream) != hipSuccess) return;
    Args a{};
    for (int i = 0; i < 35; ++i) a.in[i] = (const float*)d_in[i];
    a.out = (float*)d_out; a.ws = (unsigned char*)d_ws;
#if MK_PER_PHASE
    for (int ph = 0; ph < NPHASE - 1; ++ph) { a.ph_lo = ph; a.ph_hi = ph + 1; hipLaunchKernelGGL(mk_fwd, dim3(grid), dim3(NTHR), LDS_BYTES, stream, a); }
#else
    a.ph_lo = 0; a.ph_hi = NPHASE; hipLaunchKernelGGL(mk_fwd, dim3(grid), dim3(NTHR), LDS_BYTES, stream, a);
#endif
}
```
